# Optimizing an MI355X kernel written in HIP

```python
import jax, jax.numpy as jnp
from jax import lax
import numpy as np

D_MODEL = 1024
BATCH = 16
SEQ = 2048
DEPTH = 4

CHUNK = 64
N_EVEN = (DEPTH + 1) // 2
N_ODD = DEPTH // 2

A_WIDTH = D_MODEL // 2
A_HEAD_DIM = 128
A_HEADS = A_WIDTH // A_HEAD_DIM
A_SUB = 8
A_NSUB = CHUNK // A_SUB

B_WIDTH = D_MODEL // 2
B_HEAD_DIM = 64
B_HEADS = B_WIDTH // B_HEAD_DIM
B_DECAY_LORA = 64
B_ICL_LORA = 64
B_VRES_LORA = 32

C_WIDTH = D_MODEL
C_BLOCKS = 4
C_BLOCK_DIM = C_WIDTH // C_BLOCKS
C_CONV = 4
C_POW = 8.0

EVEN_SPLITS = (A_WIDTH, 2 * A_WIDTH, 3 * A_WIDTH, 4 * A_WIDTH, 4 * A_WIDTH + B_WIDTH, 4 * A_WIDTH + 2 * B_WIDTH, 4 * A_WIDTH + 3 * B_WIDTH, 4 * A_WIDTH + 4 * B_WIDTH)
EVEN_COLS = 4 * A_WIDTH + 5 * B_WIDTH
ODD_COLS = 2 * C_WIDTH

DEEPNORM_ALPHA = (2.0 * DEPTH) ** 0.25
DEEPNORM_BETA = (8.0 * DEPTH) ** -0.25
LN_EPS = 1e-5
RMS_EPS = 1e-6
B_GN_EPS = B_HEAD_DIM * 1e-5

kernel_name = 'hybrid_hgrn2_rwkv7_rglru_deepnorm_encoder'


def layer_norm(x, g, b):
    xf = x.astype(jnp.float32)
    mu = jnp.mean(xf, -1, keepdims=True)
    var = jnp.mean(jnp.square(xf - mu), -1, keepdims=True)
    return ((xf - mu) * lax.rsqrt(var + LN_EPS) * g.astype(jnp.float32) + b.astype(jnp.float32)).astype(x.dtype)


def token_shift(u):
    return jnp.pad(u, ((0, 0), (1, 0), (0, 0)))[:, :-1]


def hgrn2_chunkwise(q, f_pre, i, lb, norm_g):
    f32 = jnp.float32
    bsz, seq, _ = q.shape
    n_chunks = seq // CHUNK
    shp = (bsz, n_chunks, CHUNK, A_HEADS, A_HEAD_DIM)
    sb_shp = (bsz, n_chunks, A_NSUB, A_SUB, A_HEADS, A_HEAD_DIM)
    lb = lb.astype(f32)
    z = f_pre.astype(f32)
    log_f = jnp.log(lb + (1.0 - lb) * jax.nn.sigmoid(z)).reshape(shp)
    k = ((1.0 - lb) * jax.nn.sigmoid(-z)).reshape(shp)
    q = q.astype(f32).reshape(shp)
    i = i.astype(f32).reshape(shp)
    b = jnp.cumsum(log_f, axis=2)
    b_last = b[:, :, -1:]
    bs = b.reshape(sb_shp)
    qs = q.reshape(sb_shp)
    ks = k.reshape(sb_shp)
    i_s = i.reshape(sb_shp)
    pos = jnp.arange(A_SUB)
    diag_mask = (pos[:, None] >= pos[None, :])[:, :, None, None]
    rel = bs[:, :, :, :, None] - bs[:, :, :, None, :]
    dec = jnp.where(diag_mask, jnp.exp(jnp.minimum(rel, 0.0)), 0.0)
    s_diag = jnp.einsum('bcnthk,bcnshk,bcntshk->bcnhts', qs, ks, dec)
    o_diag = jnp.einsum('bcnhts,bcnshv->bcnthv', s_diag, i_s)
    b_start = (bs - log_f.reshape(sb_shp))[:, :, :, :1]
    q_off = qs * jnp.exp(bs - b_start)
    off_mask = ((jnp.arange(CHUNK) // A_SUB)[None, :] < jnp.arange(A_NSUB)[:, None])[:, :, None, None]
    k_off = jnp.where(off_mask, k[:, :, None] * jnp.exp(jnp.minimum(b_start - b[:, :, None], 0.0)), 0.0)
    s_off = jnp.einsum('bcnthk,bcnshk->bcnhts', q_off, k_off)
    o_off = jnp.einsum('bcnhts,bcshv->bcnthv', s_off, i)
    o_intra = (o_diag + o_off).reshape(shp)
    d_state = jnp.einsum('bcshk,bcshv->bchkv', k * jnp.exp(b_last - b), i)
    chunk_decay = jnp.exp(b_last[:, :, 0])

    def step(S, inp):
        dc, dS = inp
        return dc[..., None] * S + dS, S

    S0 = jnp.zeros((bsz, A_HEADS, A_HEAD_DIM, A_HEAD_DIM), f32)
    _, S_in = lax.scan(step, S0, (jnp.moveaxis(chunk_decay, 1, 0), jnp.moveaxis(d_state, 1, 0)))
    S_in = jnp.moveaxis(S_in, 0, 1)
    o_inter = jnp.einsum('bcthk,bchkv->bcthv', q * jnp.exp(b), S_in)
    o = (o_intra + o_inter).reshape(bsz, seq, A_HEADS, A_HEAD_DIM)
    o = o * lax.rsqrt(jnp.mean(o * o, -1, keepdims=True) + RMS_EPS)
    return o.reshape(bsz, seq, A_WIDTH) * norm_g.astype(f32)


def rwkv7_scan(r, w, k, v, a, b):
    bsz, _, n_heads, n = r.shape

    def step(S, inp):
        r_t, w_t, k_t, v_t, a_t, b_t = inp
        sa = jnp.einsum('bhvk,bhk->bhv', S, a_t)
        S = S * w_t[:, :, None, :] + sa[..., None] * b_t[:, :, None, :] + v_t[..., None] * k_t[:, :, None, :]
        return S, jnp.einsum('bhvk,bhk->bhv', S, r_t)

    xs = (jnp.moveaxis(r, 1, 0), jnp.moveaxis(w, 1, 0), jnp.moveaxis(k, 1, 0), jnp.moveaxis(v, 1, 0), jnp.moveaxis(a, 1, 0), jnp.moveaxis(b, 1, 0))
    S0 = jnp.zeros((bsz, n_heads, n, n), jnp.float32)
    _, y = lax.scan(step, S0, xs)
    return jnp.moveaxis(y, 0, 1)


def rwkv7_mix(rB, kB, vB, zB, mu, w0, w1, w2, a0, a1, a2, k_k, k_a, r_k, gn_g, gn_b, v_first, vres):
    f32 = jnp.float32
    bsz, seq, _ = rB.shape
    hn = (B_HEADS, B_HEAD_DIM)

    def heads(t):
        return t.astype(f32).reshape(bsz, seq, B_HEADS, B_HEAD_DIM)

    def lerp(u, m):
        return u + (token_shift(u) - u) * m

    r = lerp(rB, mu[0])
    k = lerp(kB, mu[1])
    v = lerp(vB, mu[2])
    z_delta = token_shift(zB) - zB
    zw = zB + z_delta * mu[3]
    za = zB + z_delta * mu[4]
    w_log = -jax.nn.softplus(-(w0 + jnp.tanh(zw @ w1) @ w2).astype(f32)) - 0.5
    decay = jnp.exp(-jnp.exp(w_log))
    if vres is None:
        v_first = v
    else:
        v_mu, v0, v1, v2 = vres
        zv = zB + z_delta * v_mu
        v = v + (v_first - v) * jax.nn.sigmoid(v0 + (zv @ v1) @ v2)
    icl = heads(jax.nn.sigmoid((a0 + (za @ a1) @ a2).astype(f32)))
    kk = heads(k * k_k)
    kk = kk * lax.rsqrt(jnp.maximum(jnp.sum(kk * kk, -1, keepdims=True), 1e-24))
    kh = heads(k) * (1.0 + (icl - 1.0) * k_a.astype(f32).reshape(hn))
    rh = heads(r)
    vh = heads(v)
    y = rwkv7_scan(rh, heads(decay), kh, vh, -kk, kk * icl)
    y_mu = jnp.mean(y, -1, keepdims=True)
    y_var = jnp.mean(jnp.square(y - y_mu), -1, keepdims=True)
    y = (y - y_mu) * lax.rsqrt(y_var + B_GN_EPS) * gn_g.astype(f32).reshape(hn) + gn_b.astype(f32).reshape(hn)
    y = y + jnp.sum(rh * kh * r_k.astype(f32), -1, keepdims=True) * vh
    return y.reshape(bsz, seq, B_WIDTH), v_first


def rglru_branch(xb, conv_w, conv_b, wa, ba, wx, bx, lam):
    f32 = jnp.float32
    bsz, seq, _ = xb.shape
    xc = lax.conv_general_dilated(xb.astype(f32), conv_w.astype(f32)[:, None, :], (1,), [(C_CONV - 1, 0)], dimension_numbers=('NWC', 'WIO', 'NWC'), feature_group_count=C_WIDTH) + conv_b.astype(f32)
    xh = xc.reshape(bsz, seq, C_BLOCKS, C_BLOCK_DIM)
    gate_r = jax.nn.sigmoid(jnp.einsum('btgi,gij->btgj', xh, wa.astype(f32)) + ba.astype(f32)).reshape(bsz, seq, C_WIDTH)
    gate_i = jax.nn.sigmoid(jnp.einsum('btgi,gij->btgj', xh, wx.astype(f32)) + bx.astype(f32)).reshape(bsz, seq, C_WIDTH)
    log_a = -C_POW * gate_r * jax.nn.softplus(-lam.astype(f32))
    a = jnp.exp(log_a)
    u = jnp.sqrt(-jnp.expm1(2.0 * log_a)) * (gate_i * xc)

    def combine(left, right):
        a_l, b_l = left
        a_r, b_r = right
        return a_l * a_r, a_r * b_l + b_r

    _, h = lax.associative_scan(combine, (a, u), axis=1)
    return h


def setup_inputs(seed: int = 0) -> dict:
    key = jax.random.key(seed)
    ks = iter(jax.random.split(key, 48))
    f32 = jnp.float32

    def nrm(shape, s):
        return jax.random.normal(next(ks), shape, f32) * s

    def uni(shape, lo, hi):
        return jax.random.uniform(next(ks), shape, f32, lo, hi)

    D = D_MODEL
    nv = N_EVEN - 1
    p_lam = uni((N_ODD, C_WIDTH), 0.9, 0.999) ** (1.0 / C_POW)
    return {
        'x': nrm((BATCH, SEQ, D), 1.0),
        'c': nrm((BATCH, D), 1.0),
        'ada_w': nrm((DEPTH, D, 3 * D), 0.1 * D ** -0.5),
        'ada_b': nrm((DEPTH, 3 * D), 0.01),
        'ln_g': 1.0 + nrm((DEPTH, D), 0.02),
        'ln_b': nrm((DEPTH, D), 0.02),
        'ev_w_in': nrm((N_EVEN, D, EVEN_COLS), D ** -0.5),
        'ev_w_out': nrm((N_EVEN, A_WIDTH + B_WIDTH, D), DEEPNORM_BETA * (A_WIDTH + B_WIDTH) ** -0.5),
        'a_lb_logits': nrm((N_EVEN, A_WIDTH), 0.5),
        'a_norm_g': 1.0 + nrm((N_EVEN, A_WIDTH), 0.02),
        'b_mu': uni((N_EVEN, 5, B_WIDTH), 0.0, 1.0),
        'b_w0': uni((N_EVEN, B_WIDTH), -6.0, -0.5),
        'b_w1': nrm((N_EVEN, B_WIDTH, B_DECAY_LORA), B_WIDTH ** -0.5),
        'b_w2': nrm((N_EVEN, B_DECAY_LORA, B_WIDTH), 0.1 * B_DECAY_LORA ** -0.5),
        'b_a0': nrm((N_EVEN, B_WIDTH), 0.1),
        'b_a1': nrm((N_EVEN, B_WIDTH, B_ICL_LORA), B_WIDTH ** -0.5),
        'b_a2': nrm((N_EVEN, B_ICL_LORA, B_WIDTH), 0.1 * B_ICL_LORA ** -0.5),
        'b_kk': 0.85 + nrm((N_EVEN, B_WIDTH), 0.02),
        'b_ka': 1.0 + nrm((N_EVEN, B_WIDTH), 0.02),
        'b_rk': nrm((N_EVEN, B_HEADS, B_HEAD_DIM), 0.1),
        'b_gn_g': 1.0 + nrm((N_EVEN, B_WIDTH), 0.02),
        'b_gn_b': nrm((N_EVEN, B_WIDTH), 0.02),
        'b_vmu': uni((nv, B_WIDTH), 0.0, 1.0),
        'b_v0': 1.0 + nrm((nv, B_WIDTH), 0.1),
        'b_v1': nrm((nv, B_WIDTH, B_VRES_LORA), B_WIDTH ** -0.5),
        'b_v2': nrm((nv, B_VRES_LORA, B_WIDTH), 0.1 * B_VRES_LORA ** -0.5),
        'od_w_in': nrm((N_ODD, D, ODD_COLS), D ** -0.5),
        'od_conv_w': nrm((N_ODD, C_CONV, C_WIDTH), C_CONV ** -0.5),
        'od_conv_b': nrm((N_ODD, C_WIDTH), 0.01),
        'od_wa': nrm((N_ODD, C_BLOCKS, C_BLOCK_DIM, C_BLOCK_DIM), C_BLOCK_DIM ** -0.5),
        'od_ba': nrm((N_ODD, C_BLOCKS, C_BLOCK_DIM), 0.01),
        'od_wx': nrm((N_ODD, C_BLOCKS, C_BLOCK_DIM, C_BLOCK_DIM), C_BLOCK_DIM ** -0.5),
        'od_bx': nrm((N_ODD, C_BLOCKS, C_BLOCK_DIM), 0.01),
        'od_lam': jnp.log(p_lam) - jnp.log1p(-p_lam),
        'od_w_out': nrm((N_ODD, C_WIDTH, D), DEEPNORM_BETA * C_WIDTH ** -0.5),
    }


def reference(x, c, ada_w, ada_b, ln_g, ln_b, ev_w_in, ev_w_out, a_lb_logits, a_norm_g, b_mu, b_w0, b_w1, b_w2, b_a0, b_a1, b_a2, b_kk, b_ka, b_rk, b_gn_g, b_gn_b, b_vmu, b_v0, b_v1, b_v2, od_w_in, od_conv_w, od_conv_b, od_wa, od_ba, od_wx, od_bx, od_lam, od_w_out):
    f32 = jnp.float32
    cond = jax.nn.silu(c)
    p_lb = jax.nn.softmax(a_lb_logits.astype(f32), axis=0)
    lbs = jnp.cumsum(p_lb, axis=0) - p_lb[0]
    v_first = None
    for l in range(DEPTH):
        mod = cond @ ada_w[l] + ada_b[l]
        shift, scale, gate = jnp.split(mod, 3, axis=-1)
        h = x * (1.0 + scale[:, None]) + shift[:, None]
        if l % 2 == 0:
            e = l // 2
            u = h @ ev_w_in[e]
            qA, fA, iA, gA, rB, kB, vB, zB, gB = jnp.split(u, EVEN_SPLITS, axis=-1)
            oA = hgrn2_chunkwise(qA, fA, iA, lbs[e], a_norm_g[e])
            vres = None if e == 0 else (b_vmu[e - 1], b_v0[e - 1], b_v1[e - 1], b_v2[e - 1])
            oB, vf = rwkv7_mix(rB, kB, vB, zB, b_mu[e], b_w0[e], b_w1[e], b_w2[e], b_a0[e], b_a1[e], b_a2[e], b_kk[e], b_ka[e], b_rk[e], b_gn_g[e], b_gn_b[e], v_first, vres)
            if e == 0:
                v_first = vf
            mixed = jnp.concatenate([oA * jax.nn.silu(gA.astype(f32)), oB * jax.nn.silu(gB.astype(f32))], axis=-1).astype(x.dtype)
            y = mixed @ ev_w_out[e]
        else:
            o = l // 2
            u = h @ od_w_in[o]
            xC, gC = jnp.split(u, 2, axis=-1)
            hC = rglru_branch(xC, od_conv_w[o], od_conv_b[o], od_wa[o], od_ba[o], od_wx[o], od_bx[o], od_lam[o])
            y = (hC * jax.nn.silu(gC.astype(f32))).astype(x.dtype) @ od_w_out[o]
        x = layer_norm(DEEPNORM_ALPHA * x + (1.0 + gate[:, None]) * y, ln_g[l], ln_b[l])
    return x
```

```cpp
#include <hip/hip_runtime.h>
#include <hip/hip_bf16.h>
#include <hip/hip_cooperative_groups.h>
#include <cstdio>
namespace cg = cooperative_groups;

typedef unsigned short bf16_t;
using bf16x8 = __attribute__((ext_vector_type(8))) short;
using f32x4 = __attribute__((ext_vector_type(4))) float;

#define NTOK 32768
#define DM 1024
#define SEQ 2048
#define NBATCH 16
#define UE 4480
#define UO 2048
#define C_QA 0
#define C_FA 512
#define C_IA 1024
#define C_GA 1536
#define C_RB 2048
#define C_KB 2560
#define C_VB 3072
#define C_GB 3584
#define C_ZC 4096
#define C_ZP 4256
#define ALPHA 1.681792830507429f
#define SMEM_BYTES 61824
#define NTHR 256
#ifndef NVGPR_CAP
#define NVGPR_CAP 256
#endif
#ifndef REP_H
#define REP_H 1
#endif
#ifndef REP_R
#define REP_R 1
#endif
#ifndef REP_PRE
#define REP_PRE 1
#endif
#ifndef REP_HP
#define REP_HP 1
#endif
#ifndef REP_GIN
#define REP_GIN 1
#endif
#ifndef REP_MIX
#define REP_MIX 1
#endif
#ifndef REP_ODD
#define REP_ODD 1
#endif

#ifdef SKIP_PREP
#define PH_PREP(x)
#else
#define PH_PREP(x) x
#endif
#ifdef SKIP_H0
#define PH_H0(x)
#else
#define PH_H0(x) x
#endif
#ifdef SKIP_GIN
#define PH_GIN(x)
#else
#define PH_GIN(x) x
#endif
#ifdef SKIP_MIX
#define PH_MIX(x)
#else
#define PH_MIX(x) x
#endif
#ifdef SKIP_HPOST
#define PH_HPOST(x)
#else
#define PH_HPOST(x) x
#endif
#ifdef SKIP_CONV
#define PH_CONV(x)
#else
#define PH_CONV(x) x
#endif
#ifdef SKIP_GATES
#define PH_GATES(x)
#else
#define PH_GATES(x) x
#endif
#ifdef SKIP_SCAN
#define PH_SCAN(x)
#else
#define PH_SCAN(x) x
#endif
#ifdef SKIP_GOUT
#define PH_GOUT(x)
#else
#define PH_GOUT(x) x
#endif
#ifdef SKIP_LN
#define PH_LN(x)
#else
#define PH_LN(x) x
#endif

struct Params {
  const float *x, *c, *ada_w, *ada_b, *ln_g, *ln_b, *ev_w_in, *ev_w_out, *a_lb, *a_ng, *b_mu, *b_w0, *b_w1, *b_w2,
      *b_a0, *b_a1, *b_a2, *b_kk, *b_ka, *b_rk, *b_gng, *b_gnb, *b_vmu, *b_v0, *b_v1, *b_v2, *od_w_in, *od_cw, *od_cb,
      *od_wa, *od_ba, *od_wx, *od_bx, *od_lam, *od_w_out;
  float* out;
  float* mod;
  bf16_t *wev_in, *wev_out, *wod_in, *wod_out, *wg, *act, *vfirst, *u;
  float* oraw;
  bf16_t* la;
  bf16_t* uin;
  unsigned* bar;
  bf16_t* mixb;
  int never;
  int pad0;
};

__device__ __forceinline__ int otid() {
  int t = threadIdx.x;
  asm volatile("" : "+v"(t));
  return t;
}
typedef __bf16 hwbf16x2_t __attribute__((ext_vector_type(2)));
typedef float hwf32x2_t __attribute__((ext_vector_type(2)));
__device__ __forceinline__ unsigned short f2bf(float f) {
  __bf16 h = (__bf16)f;
  return __builtin_bit_cast(unsigned short, h);
}
__device__ __forceinline__ float bf2f(unsigned short h) { return __uint_as_float(((unsigned)h) << 16); }
__device__ __forceinline__ unsigned pack2(float a, float b) {
  hwf32x2_t v = {a, b};
  hwbf16x2_t h = __builtin_convertvector(v, hwbf16x2_t);
  return __builtin_bit_cast(unsigned, h);
}
__device__ __forceinline__ float sigm(float x) { return __builtin_amdgcn_rcpf(1.f + __expf(-x)); }
__device__ __forceinline__ float silu(float x) { return x * __builtin_amdgcn_rcpf(1.f + __expf(-x)); }
__device__ __forceinline__ float softplus(float x) { return fmaxf(x, 0.f) + log1pf(__expf(-fabsf(x))); }

__device__ __forceinline__ int gate_perm(int col, int which) {
  return (col >> 6) * 128 + ((col & 63) >> 5) * 64 + ((((col >> 4) & 1) * 2 + which) * 16) + (col & 15);
}

__device__ void transpose_tile(const float* __restrict__ src, int lds_, int r0, int c0, bf16_t* __restrict__ dst,
                               int ldd, int dr0, int dc0, int mode, float* tile) {
  const int tid = otid();
  const int cx = tid & 63, ry = tid >> 6;
#pragma unroll
  for (int i = 0; i < 16; ++i) {
    int row = ry + i * 4;
    tile[row * 65 + cx] = src[(size_t)(r0 + row) * lds_ + c0 + cx];
  }
  __syncthreads();
#pragma unroll
  for (int i = 0; i < 16; ++i) {
    int n = ry + i * 4;
    int drow = (mode == 0) ? (dr0 + n) : gate_perm(c0 + n, mode - 1);
    dst[(size_t)drow * ldd + dc0 + cx] = f2bf(tile[cx * 65 + n]);
  }
  __syncthreads();
}

__device__ void phase_prep(const Params& p, char* smem) {
  float* fs = (float*)smem;
  const int tid = otid();
  const int nT0 = 1792, nT1 = 256, nT2 = 512, nT3 = 1024, nT4 = 512, nT5 = 256, nZ = 2, nM = 192, nC = 320;
  const int total = nT0 + nT1 + nT2 + nT3 + nT4 + nT5 + nZ + nM + nC;
  for (int unit = blockIdx.x; unit < total; unit += gridDim.x) {
    int u = unit;
    if (u < nT0) {
      int e = u / 896, r = u % 896, kt = r / 56, nt = r % 56;
      transpose_tile(p.ev_w_in + (size_t)e * 1024 * 4608, 4608, kt * 64, nt * 64, p.wev_in + (size_t)e * UE * 1024, 1024,
                     nt * 64, kt * 64, 0, fs);
      continue;
    }
    u -= nT0;
    if (u < nT1) {
      int e = u / 128, r = u % 128, kt = r / 8, nt = r % 8;
      transpose_tile(p.ev_w_in + (size_t)e * 1024 * 4608, 4608, kt * 64, 4096 + nt * 64,
                     p.wev_in + (size_t)e * UE * 1024, 1024, 3584 + nt * 64, kt * 64, 0, fs);
      continue;
    }
    u -= nT1;
    if (u < nT2) {
      int e = u / 256, r = u % 256, kt = r / 16, nt = r % 16;
      transpose_tile(p.ev_w_out + (size_t)e * 1024 * 1024, 1024, kt * 64, nt * 64, p.wev_out + (size_t)e * 1024 * 1024,
                     1024, nt * 64, kt * 64, 0, fs);
      continue;
    }
    u -= nT2;
    if (u < nT3) {
      int o = u / 512, r = u % 512, kt = r / 32, nt = r % 32;
      transpose_tile(p.od_w_in + (size_t)o * 1024 * 2048, 2048, kt * 64, nt * 64, p.wod_in + (size_t)o * 2048 * 1024,
                     1024, nt * 64, kt * 64, 0, fs);
      continue;
    }
    u -= nT3;
    if (u < nT4) {
      int o = u / 256, r = u % 256, kt = r / 16, nt = r % 16;
      transpose_tile(p.od_w_out + (size_t)o * 1024 * 1024, 1024, kt * 64, nt * 64, p.wod_out + (size_t)o * 1024 * 1024,
                     1024, nt * 64, kt * 64, 0, fs);
      continue;
    }
    u -= nT4;
    if (u < nT5) {
      int mat = u / 16, r = u % 16, kt = r / 4, nt = r % 4;
      int o = mat / 8, which = (mat / 4) & 1, g = mat & 3;
      const float* src = (which ? p.od_wx : p.od_wa) + (size_t)(o * 4 + g) * 256 * 256;
      transpose_tile(src, 256, kt * 64, nt * 64, p.wg + (size_t)(o * 4 + g) * 512 * 256, 256, 0, kt * 64, 1 + which, fs);
      continue;
    }
    u -= nT5;
    if (u < nZ) {
      uint4 z = make_uint4(0, 0, 0, 0);
      uint4* d = (uint4*)(p.wev_in + (size_t)u * UE * 1024 + (size_t)4416 * 1024);
      for (int i = tid; i < 64 * 1024 * 2 / 16; i += NTHR) d[i] = z;
      continue;
    }
    u -= nZ;
    if (u < nM) {
      int l = u / 48, c0 = (u % 48) * 64;
      int cc = tid & 63, kq = tid >> 6;
      float acc[16];
#pragma unroll
      for (int b = 0; b < 16; ++b) acc[b] = 0.f;
      const float* w = p.ada_w + (size_t)l * 1024 * 3072 + c0 + cc;
      float* sc = fs + kq * 1024;
      for (int ks = 0; ks < 4; ++ks) {
        const int kb = kq * 256 + ks * 64;
#pragma unroll
        for (int b = 0; b < 16; ++b) sc[cc * 16 + b] = silu(p.c[b * 1024 + kb + cc]);
        __syncthreads();
#pragma unroll 4
        for (int kk = 0; kk < 64; ++kk) {
          const float wv = w[(size_t)(kb + kk) * 3072];
          const float4 s0 = *(const float4*)(sc + kk * 16), s1 = *(const float4*)(sc + kk * 16 + 4),
                       s2 = *(const float4*)(sc + kk * 16 + 8), s3 = *(const float4*)(sc + kk * 16 + 12);
          acc[0] += s0.x * wv; acc[1] += s0.y * wv; acc[2] += s0.z * wv; acc[3] += s0.w * wv;
          acc[4] += s1.x * wv; acc[5] += s1.y * wv; acc[6] += s1.z * wv; acc[7] += s1.w * wv;
          acc[8] += s2.x * wv; acc[9] += s2.y * wv; acc[10] += s2.z * wv; acc[11] += s2.w * wv;
          acc[12] += s3.x * wv; acc[13] += s3.y * wv; acc[14] += s3.z * wv; acc[15] += s3.w * wv;
        }
        __syncthreads();
      }
#pragma unroll
      for (int b = 0; b < 16; ++b) fs[(kq * 16 + b) * 64 + cc] = acc[b];
      __syncthreads();
      for (int i = tid; i < 16 * 64; i += NTHR) {
        int b = i >> 6, c2 = i & 63;
        float sm = fs[(0 * 16 + b) * 64 + c2] + fs[(1 * 16 + b) * 64 + c2] + fs[(2 * 16 + b) * 64 + c2] +
                   fs[(3 * 16 + b) * 64 + c2];
        p.mod[((size_t)l * 16 + b) * 3072 + c0 + c2] = sm + p.ada_b[l * 3072 + c0 + c2];
      }
      __syncthreads();
      continue;
    }
    u -= nM;
    {
      int e = u / 160, r = u % 160, cp = r / 80, r2 = r % 80, dt = r2 / 5, jt = r2 % 5;
      int d0 = dt * 64, j0 = jt * 32;
      float* sA = fs;
      float* sB = fs + 64 * 33;
      const float* M = nullptr;
      const float* mu = nullptr;
      int ldm = 64, jm = 0;
      if (jt < 2) { M = p.b_w1 + (size_t)e * 512 * 64; mu = p.b_mu + (size_t)e * 5 * 512 + 3 * 512; ldm = 64; jm = j0; }
      else if (jt < 4) { M = p.b_a1 + (size_t)e * 512 * 64; mu = p.b_mu + (size_t)e * 5 * 512 + 4 * 512; ldm = 64; jm = j0 - 64; }
      else if (e >= 1) { M = p.b_v1 + (size_t)(e - 1) * 512 * 32; mu = p.b_vmu + (size_t)(e - 1) * 512; ldm = 32; jm = 0; }
      float acc[8];
#pragma unroll
      for (int i = 0; i < 8; ++i) acc[i] = 0.f;
      const int jj = tid & 31, dg = tid >> 5;
      if (M != nullptr) {
        const float* win = p.ev_w_in + (size_t)e * 1024 * 4608 + 3584;
        for (int z0 = 0; z0 < 512; z0 += 32) {
          for (int i = tid; i < 64 * 32; i += NTHR) {
            int dd = i >> 5, zz = i & 31;
            sA[dd * 33 + zz] = win[(size_t)(d0 + dd) * 4608 + z0 + zz];
          }
          for (int i = tid; i < 32 * 32; i += NTHR) {
            int zz = i >> 5, j2 = i & 31;
            float m = mu[z0 + zz];
            float s = cp ? m : (1.f - m);
            sB[zz * 33 + j2] = s * M[(size_t)(z0 + zz) * ldm + jm + j2];
          }
          __syncthreads();
#pragma unroll 8
          for (int zz = 0; zz < 32; ++zz) {
            float bv = sB[zz * 33 + jj];
#pragma unroll
            for (int i = 0; i < 8; ++i) acc[i] += sA[(dg * 8 + i) * 33 + zz] * bv;
          }
          __syncthreads();
        }
      }
      bf16_t* dst = p.wev_in + (size_t)e * UE * 1024 + (size_t)(4096 + cp * 160 + j0 + jj) * 1024 + d0 + dg * 8;
#pragma unroll
      for (int i = 0; i < 8; ++i) dst[i] = f2bf(acc[i]);
    }
  }
}

__device__ void phase_h0(const Params& p) {
  const size_t n8 = (size_t)NTOK * DM / 8;
  for (size_t i = (size_t)blockIdx.x * NTHR + otid(); i < n8; i += (size_t)gridDim.x * NTHR) {
    size_t e0 = i * 8;
    int tok = (int)(e0 >> 10), col = (int)(e0 & 1023);
    int b = tok >> 11;
    const float* md = p.mod + (size_t)b * 3072;
    float4 x0 = *(const float4*)(p.x + e0), x1 = *(const float4*)(p.x + e0 + 4);
    float4 sh0 = *(const float4*)(md + col), sh1 = *(const float4*)(md + col + 4);
    float4 sc0 = *(const float4*)(md + 1024 + col), sc1 = *(const float4*)(md + 1024 + col + 4);
    uint4 o;
    o.x = pack2(x0.x * (1.f + sc0.x) + sh0.x, x0.y * (1.f + sc0.y) + sh0.y);
    o.y = pack2(x0.z * (1.f + sc0.z) + sh0.z, x0.w * (1.f + sc0.w) + sh0.w);
    o.z = pack2(x1.x * (1.f + sc1.x) + sh1.x, x1.y * (1.f + sc1.y) + sh1.y);
    o.w = pack2(x1.z * (1.f + sc1.z) + sh1.z, x1.w * (1.f + sc1.w) + sh1.w);
    *(uint4*)(p.act + e0) = o;
  }
}

#define GEMM_SLOTS_DECL uint4 rA0_0, rA1_0, rA2_0, rA3_0, rB0_0, rB1_0, rB2_0, rB3_0, rA0_1, rA1_1, rA2_1, rA3_1, rB0_1, rB1_1, rB2_1, rB3_1;
#define GEMM_SLOTS_ARGS rA0_0, rA1_0, rA2_0, rA3_0, rB0_0, rB1_0, rB2_0, rB3_0, rA0_1, rA1_1, rA2_1, rA3_1, rB0_1, rB1_1, rB2_1, rB3_1
__device__ __forceinline__ void gemm_mainloop(const bf16_t* __restrict__ A, int lda, const bf16_t* __restrict__ Bt,
                                              int ldb, int K, f32x4 (&acc)[4][4], char* smem,
                                              const bf16_t* __restrict__ A2, int lda2, int ksplit,
                                              uint4& rA0_0, uint4& rA1_0, uint4& rA2_0, uint4& rA3_0, uint4& rB0_0, uint4& rB1_0, uint4& rB2_0, uint4& rB3_0, uint4& rA0_1, uint4& rA1_1, uint4& rA2_1, uint4& rA3_1, uint4& rB0_1, uint4& rB1_1, uint4& rB2_1, uint4& rB3_1,
                                              bool preloaded, const bf16_t* __restrict__ nextA, const bf16_t* __restrict__ nextBt) {
  bf16_t* sA = (bf16_t*)smem;
  bf16_t* sB = sA + 128 * 64;
  const int tid = otid(), lane = tid & 63, wid = tid >> 6, wr = wid >> 1, wc = wid & 1, fr = lane & 15,
            fq = lane >> 4;
  const int lrow = tid >> 3, lc = tid & 7;
  const int wofs = lrow * 64 + ((lc ^ ((lrow >> 1) & 7)) * 8);
  const int rs0 = ((fq) ^ ((fr >> 1) & 7)) * 8, rs1 = ((4 + fq) ^ ((fr >> 1) & 7)) * 8;
  const bf16_t* ga = A + (size_t)lrow * lda + lc * 8;
  const bf16_t* ga2 = A2 + (size_t)lrow * lda2 + lc * 8;
  const size_t a32b = (size_t)32 * lda2;
  const bf16_t* gb = Bt + (size_t)lrow * ldb + lc * 8;
  const size_t a32 = (size_t)32 * lda, b32 = (size_t)32 * ldb;
#pragma unroll
  for (int i = 0; i < 4; ++i)
#pragma unroll
    for (int j = 0; j < 4; ++j) acc[i][j] = (f32x4){0.f, 0.f, 0.f, 0.f};
  const int nk = K >> 6;
#define LD_SLOT(s, kt_)                                                                   \
  {                                                                                       \
    const bf16_t* pa_ = ((kt_) < ksplit) ? (ga + (kt_)*64) : (ga2 + ((kt_)-ksplit) * 64);  \
    const size_t st_ = ((kt_) < ksplit) ? a32 : a32b;                                      \
    rA0_##s = *(const uint4*)(pa_);                                                       \
    rA1_##s = *(const uint4*)(pa_ + st_);                                                 \
    rA2_##s = *(const uint4*)(pa_ + 2 * st_);                                             \
    rA3_##s = *(const uint4*)(pa_ + 3 * st_);                                             \
  }                                                                                       \
  rB0_##s = *(const uint4*)(gb + (kt_)*64);                 \
  rB1_##s = *(const uint4*)(gb + b32 + (kt_)*64);           \
  rB2_##s = *(const uint4*)(gb + 2 * b32 + (kt_)*64);       \
  rB3_##s = *(const uint4*)(gb + 3 * b32 + (kt_)*64);
#define ST_SLOT(s)                                \
  *(uint4*)(sA + wofs) = rA0_##s;                 \
  *(uint4*)(sA + wofs + 32 * 64) = rA1_##s;       \
  *(uint4*)(sA + wofs + 64 * 64) = rA2_##s;       \
  *(uint4*)(sA + wofs + 96 * 64) = rA3_##s;       \
  *(uint4*)(sB + wofs) = rB0_##s;                 \
  *(uint4*)(sB + wofs + 32 * 64) = rB1_##s;       \
  *(uint4*)(sB + wofs + 64 * 64) = rB2_##s;       \
  *(uint4*)(sB + wofs + 96 * 64) = rB3_##s;
  if (!preloaded) {
    LD_SLOT(0, 0)
    LD_SLOT(1, 1)
  }
  ST_SLOT(0)
  LD_SLOT(0, 2)
  __syncthreads();
#define GEMM_STEP(sl)                                                                                             \
  {                                                                                                               \
    const bf16_t* pa = sA + (wr * 64 + fr) * 64;                                                                  \
    const bf16_t* pb = sB + (wc * 64 + fr) * 64;                                                                  \
    bf16x8 af[4], bfr[4];                                                                                         \
    _Pragma("unroll") for (int t = 0; t < 4; ++t) {                                                               \
      af[t] = *(const bf16x8*)(pa + t * 16 * 64 + rs0);                                                           \
      bfr[t] = *(const bf16x8*)(pb + t * 16 * 64 + rs0);                                                          \
    }                                                                                                             \
    __builtin_amdgcn_s_setprio(1);                                                                                \
    _Pragma("unroll") for (int mt = 0; mt < 4; ++mt) _Pragma("unroll") for (int nt = 0; nt < 4; ++nt)             \
        acc[mt][nt] = __builtin_amdgcn_mfma_f32_16x16x32_bf16(bfr[nt], af[mt], acc[mt][nt], 0, 0, 0);             \
    __builtin_amdgcn_s_setprio(0);                                                                                \
    _Pragma("unroll") for (int t = 0; t < 4; ++t) {                                                               \
      af[t] = *(const bf16x8*)(pa + t * 16 * 64 + rs1);                                                           \
      bfr[t] = *(const bf16x8*)(pb + t * 16 * 64 + rs1);                                                          \
    }                                                                                                             \
    __builtin_amdgcn_s_setprio(1);                                                                                \
    _Pragma("unroll") for (int mt = 0; mt < 4; ++mt) _Pragma("unroll") for (int nt = 0; nt < 4; ++nt)             \
        acc[mt][nt] = __builtin_amdgcn_mfma_f32_16x16x32_bf16(bfr[nt], af[mt], acc[mt][nt], 0, 0, 0);             \
    __builtin_amdgcn_s_setprio(0);                                                                                \
    __syncthreads();                                                                                              \
    if (kt + 1 < nk) { ST_SLOT(sl) }                                                                              \
    if (kt + 3 < nk) { LD_SLOT(sl, kt + 3) }                                                                      \
    __syncthreads();                                                                                              \
  }
  for (int kt0 = 0; kt0 < nk; kt0 += 2) {
    { const int kt = kt0; GEMM_STEP(1) }
    { const int kt = kt0 + 1; GEMM_STEP(0) }
  }
  if (nextA != nullptr) {
    const bf16_t* gan = nextA + (size_t)lrow * lda + lc * 8;
    const bf16_t* gbn = nextBt + (size_t)lrow * ldb + lc * 8;
    rA0_0 = *(const uint4*)(gan);            rA1_0 = *(const uint4*)(gan + a32);
    rA2_0 = *(const uint4*)(gan + 2 * a32);  rA3_0 = *(const uint4*)(gan + 3 * a32);
    rB0_0 = *(const uint4*)(gbn);            rB1_0 = *(const uint4*)(gbn + b32);
    rB2_0 = *(const uint4*)(gbn + 2 * b32);  rB3_0 = *(const uint4*)(gbn + 3 * b32);
    rA0_1 = *(const uint4*)(gan + 64);            rA1_1 = *(const uint4*)(gan + a32 + 64);
    rA2_1 = *(const uint4*)(gan + 2 * a32 + 64);  rA3_1 = *(const uint4*)(gan + 3 * a32 + 64);
    rB0_1 = *(const uint4*)(gbn + 64);            rB1_1 = *(const uint4*)(gbn + b32 + 64);
    rB2_1 = *(const uint4*)(gbn + 2 * b32 + 64);  rB3_1 = *(const uint4*)(gbn + 3 * b32 + 64);
  }
#undef GEMM_STEP
#undef LD_SLOT
#undef ST_SLOT
}


__device__ __forceinline__ void store_tile_bf16(f32x4 (&acc)[4][4], bf16_t* __restrict__ C, int ldc, int m0, int n0,
                                                char* smem) {
  bf16_t* sC = (bf16_t*)smem;
  const int tid = otid(), lane = tid & 63, wid = tid >> 6, wr = wid >> 1, wc = wid & 1, fr = lane & 15, fq = lane >> 4;
#pragma unroll
  for (int mt = 0; mt < 4; ++mt) {
    const int m = wr * 64 + mt * 16 + fr;
#pragma unroll
    for (int nt = 0; nt < 4; ++nt) {
      const int n = wc * 64 + nt * 16 + fq * 4;
      uint2 v;
      v.x = pack2(acc[mt][nt][0], acc[mt][nt][1]);
      v.y = pack2(acc[mt][nt][2], acc[mt][nt][3]);
      *(uint2*)(sC + m * 136 + n) = v;
    }
  }
  __syncthreads();
  const int row = tid >> 4, c16 = tid & 15;
#pragma unroll
  for (int ps = 0; ps < 8; ++ps) {
    const int r = ps * 16 + row;
    const uint4 v = *(const uint4*)(sC + r * 136 + c16 * 8);
    *(uint4*)(C + (size_t)(m0 + r) * ldc + n0 + c16 * 8) = v;
  }
  __syncthreads();
}

__device__ void phase_gemm_in_range(const Params& p, const bf16_t* Wt, int ldc, int nt0, int ntn, int b0, int nb,
                                    char* smem) {
  const int ntiles = (NTOK / 128) * ntn;
  const int lane = otid() & 63, wid = otid() >> 6, wr = wid >> 1, wc = wid & 1, fr = lane & 15, fq = lane >> 4;
  const int bloc = (int)blockIdx.x - b0, tpx = ntiles >> 3, nbx = nb >> 3;
  GEMM_SLOTS_DECL
  bool preloaded = false;
  for (int lt = bloc >> 3; lt < tpx; lt += nbx) {
    const int t = (bloc & 7) * tpx + lt;
    const int m0 = (t / ntn) * 128, n0 = (nt0 + (t % ntn)) * 128;
    const bool more = (lt + nbx < tpx);
    const int t2 = (bloc & 7) * tpx + lt + nbx;
    const bf16_t* nA = more ? (p.act + (size_t)((t2 / ntn) * 128) * DM) : nullptr;
    const bf16_t* nB = more ? (Wt + (size_t)((nt0 + (t2 % ntn)) * 128) * DM) : nullptr;
    f32x4 acc[4][4];
    gemm_mainloop(p.act + (size_t)m0 * DM, DM, Wt + (size_t)n0 * DM, DM, DM, acc, smem, p.act, DM, 1 << 20, GEMM_SLOTS_ARGS, preloaded, nA, nB);
    preloaded = more;
    store_tile_bf16(acc, p.u, ldc, m0, n0, smem);
  }
}

__device__ void phase_gemm_in(const Params& p, const bf16_t* Wt, int N, int ldc, char* smem) {
  const int ntn = N / 128, ntiles = (NTOK / 128) * ntn;
  const int lane = otid() & 63, wid = otid() >> 6, wr = wid >> 1, wc = wid & 1, fr = lane & 15, fq = lane >> 4;
  const int tpx = ntiles >> 3, nbx = gridDim.x >> 3, xcd = blockIdx.x & 7;
  for (int lt = (gridDim.x == 512) ? ((((blockIdx.x >> 3) & 31) << 1) + (blockIdx.x >> 8)) : (blockIdx.x >> 3); lt < tpx; lt += nbx) {
    const int t = xcd * tpx + lt;
    const int m0 = (t / ntn) * 128, n0 = (t % ntn) * 128;
    f32x4 acc[4][4];
    GEMM_SLOTS_DECL
    gemm_mainloop(p.act + (size_t)m0 * DM, DM, Wt + (size_t)n0 * DM, DM, DM, acc, smem, p.act, DM, 1 << 20, GEMM_SLOTS_ARGS, false, nullptr, nullptr);
    store_tile_bf16(acc, p.u, ldc, m0, n0, smem);
  }
}

__device__ void phase_gemm_out(const Params& p, int l, const bf16_t* Wt, char* smem, bool splitA) {
  const int ntn = DM / 128, ntiles = (NTOK / 128) * ntn;
  const int lane = otid() & 63, wid = otid() >> 6, wr = wid >> 1, wc = wid & 1, fr = lane & 15, fq = lane >> 4;
  const float* xin = (l == 0) ? p.x : p.out;
  const int tpx = ntiles >> 3, nbx = gridDim.x >> 3, xcd = blockIdx.x & 7;
  for (int lt = (gridDim.x == 512) ? ((((blockIdx.x >> 3) & 31) << 1) + (blockIdx.x >> 8)) : (blockIdx.x >> 3); lt < tpx; lt += nbx) {
    const int t = xcd * tpx + lt;
    const int m0 = (t / ntn) * 128, n0 = (t % ntn) * 128;
    f32x4 acc[4][4];
    GEMM_SLOTS_DECL
    gemm_mainloop(p.act + (size_t)m0 * DM, DM, Wt + (size_t)n0 * DM, DM, DM, acc, smem,
                  splitA ? (p.mixb + (size_t)m0 * 512) : p.act, splitA ? 512 : DM, splitA ? 8 : (1 << 20), GEMM_SLOTS_ARGS, false, nullptr, nullptr);
    const int b = m0 >> 11;
    const float* gate = p.mod + ((size_t)l * 16 + b) * 3072 + 2048;
#pragma unroll
    for (int mt = 0; mt < 4; ++mt) {
      const int m = m0 + wr * 64 + mt * 16 + fr;
#pragma unroll
      for (int nt = 0; nt < 4; ++nt) {
        const int n = n0 + wc * 64 + nt * 16 + fq * 4;
        float4 xv = *(const float4*)(xin + (size_t)m * DM + n);
        float4 gv = *(const float4*)(gate + n);
        float4 o;
        o.x = ALPHA * xv.x + (1.f + gv.x) * acc[mt][nt][0];
        o.y = ALPHA * xv.y + (1.f + gv.y) * acc[mt][nt][1];
        o.z = ALPHA * xv.z + (1.f + gv.z) * acc[mt][nt][2];
        o.w = ALPHA * xv.w + (1.f + gv.w) * acc[mt][nt][3];
        *(float4*)(p.out + (size_t)m * DM + n) = o;
      }
    }
  }
}

__device__ void phase_ln(const Params& p, int l) {
  const int lane = otid() & 63, wid = otid() >> 6;
  const int nw = gridDim.x * 4;
  const float* g = p.ln_g + l * 1024;
  const float* bb = p.ln_b + l * 1024;
  for (int row0 = (blockIdx.x * 4 + wid) * 4; row0 < NTOK; row0 += nw * 4) {
    float4 v[4][4];
#pragma unroll
    for (int rr = 0; rr < 4; ++rr)
#pragma unroll
      for (int i = 0; i < 4; ++i) v[rr][i] = *(const float4*)(p.out + (size_t)(row0 + rr) * DM + i * 256 + lane * 4);
    float mu[4], rstd[4];
#pragma unroll
    for (int rr = 0; rr < 4; ++rr) {
      float s = 0.f;
#pragma unroll
      for (int i = 0; i < 4; ++i) s += v[rr][i].x + v[rr][i].y + v[rr][i].z + v[rr][i].w;
#pragma unroll
      for (int m = 32; m >= 1; m >>= 1) s += __shfl_xor(s, m);
      mu[rr] = s * (1.f / 1024.f);
      float q = 0.f;
#pragma unroll
      for (int i = 0; i < 4; ++i) {
        float a = v[rr][i].x - mu[rr], b2 = v[rr][i].y - mu[rr], c2 = v[rr][i].z - mu[rr], d2 = v[rr][i].w - mu[rr];
        q += a * a + b2 * b2 + c2 * c2 + d2 * d2;
      }
#pragma unroll
      for (int m = 32; m >= 1; m >>= 1) q += __shfl_xor(q, m);
      rstd[rr] = rsqrtf(q * (1.f / 1024.f) + 1e-5f);
    }
    const int b = row0 >> 11;
    const float* md = p.mod + ((size_t)(l + 1) * 16 + b) * 3072;
#pragma unroll
    for (int i = 0; i < 4; ++i) {
      const int col = i * 256 + lane * 4;
      const float4 gg = *(const float4*)(g + col), bv = *(const float4*)(bb + col);
      float4 sh = make_float4(0.f, 0.f, 0.f, 0.f), sc = sh;
      if (l < 3) { sh = *(const float4*)(md + col); sc = *(const float4*)(md + 1024 + col); }
#pragma unroll
      for (int rr = 0; rr < 4; ++rr) {
        float4 o;
        o.x = (v[rr][i].x - mu[rr]) * rstd[rr] * gg.x + bv.x;
        o.y = (v[rr][i].y - mu[rr]) * rstd[rr] * gg.y + bv.y;
        o.z = (v[rr][i].z - mu[rr]) * rstd[rr] * gg.z + bv.z;
        o.w = (v[rr][i].w - mu[rr]) * rstd[rr] * gg.w + bv.w;
        {
          f32x4 ov4 = {o.x, o.y, o.z, o.w};
          __builtin_nontemporal_store(ov4, (f32x4*)(p.out + (size_t)(row0 + rr) * DM + col));
        }
        if (l < 3) {
          uint2 h;
          h.x = pack2(o.x * (1.f + sc.x) + sh.x, o.y * (1.f + sc.y) + sh.y);
          h.y = pack2(o.z * (1.f + sc.z) + sh.z, o.w * (1.f + sc.w) + sh.w);
          *(uint2*)(p.act + (size_t)(row0 + rr) * DM + col) = h;
        }
      }
    }
  }
}

template <int CTRL>
__device__ __forceinline__ float dppf(float x) {
  return __int_as_float(__builtin_amdgcn_update_dpp(0, __float_as_int(x), CTRL, 0xf, 0xf, true));
}
__device__ __forceinline__ float red8(float x) {
  x += dppf<0xB1>(x);
  x += dppf<0x4E>(x);
  x += dppf<0x141>(x);
  return x;
}
__device__ __forceinline__ float red16(float x) {
  x = red8(x);
  x += dppf<0x140>(x);
  return x;
}
__device__ __forceinline__ float red64(float x) {
  x = red16(x);
  float a = __int_as_float(__builtin_amdgcn_readlane(__float_as_int(x), 0));
  float b = __int_as_float(__builtin_amdgcn_readlane(__float_as_int(x), 16));
  float c = __int_as_float(__builtin_amdgcn_readlane(__float_as_int(x), 32));
  float d = __int_as_float(__builtin_amdgcn_readlane(__float_as_int(x), 48));
  return (a + b) + (c + d);
}
__device__ __forceinline__ float bflo(unsigned w) { return __uint_as_float(w << 16); }
__device__ __forceinline__ float bfhi(unsigned w) { return __uint_as_float(w & 0xffff0000u); }

__device__ void hgrn2_item(const Params& p, int e, int item, char* smem) {
  const int tid = otid();
  const int b = item >> 4, h = (item >> 2) & 3, vq = item & 3;
  float* qs = (float*)smem;
  float* fsm = qs + 32 * 128;
  float* is = fsm + 32 * 128;
  float* ob = is + 32 * 32;
  const int lt = tid >> 3, lq = tid & 7;
  float lbv[16];
#pragma unroll
  for (int j = 0; j < 16; ++j) {
    int ch = h * 128 + lq * 16 + j;
    if (e == 0) lbv[j] = 0.f;
    else {
      float l0 = p.a_lb[ch], l1 = p.a_lb[512 + ch];
      lbv[j] = 1.f / (1.f + __expf(l0 - l1));
    }
  }
  const int vp = tid >> 4, ksl = tid & 15, k0 = ksl * 8;
  const int rl = tid & 63, vpl = (tid >> 4) & 3, wid4 = (tid >> 6) * 4;
  float* pb = ob + 32 * 32 + (tid >> 6) * 1024;
  typedef float f32x2v __attribute__((ext_vector_type(2)));
  f32x2v S01[8];
#pragma unroll
  for (int j = 0; j < 8; ++j) S01[j] = (f32x2v){0.f, 0.f};
  const size_t tokbase = (size_t)b * SEQ;
  uint4 q0, q1, z0, z1;
  uint2 iv;
  {
    const bf16_t* row = p.u + (tokbase + lt) * UE;
    q0 = *(const uint4*)(row + C_QA + h * 128 + lq * 16);
    q1 = *(const uint4*)(row + C_QA + h * 128 + lq * 16 + 8);
    z0 = *(const uint4*)(row + C_FA + h * 128 + lq * 16);
    z1 = *(const uint4*)(row + C_FA + h * 128 + lq * 16 + 8);
    iv = *(const uint2*)(row + C_IA + h * 128 + vq * 32 + lq * 4);
  }
  for (int c0 = 0; c0 < SEQ; c0 += 32) {
    {
      unsigned qa[8] = {q0.x, q0.y, q0.z, q0.w, q1.x, q1.y, q1.z, q1.w};
      unsigned za[8] = {z0.x, z0.y, z0.z, z0.w, z1.x, z1.y, z1.z, z1.w};
#pragma unroll
      for (int j2 = 0; j2 < 8; ++j2) {
        float qa0 = bflo(qa[j2]), qa1 = bfhi(qa[j2]);
        float za0 = bflo(za[j2]), za1 = bfhi(za[j2]);
        float f0 = lbv[2 * j2] + (1.f - lbv[2 * j2]) * sigm(za0);
        float f1 = lbv[2 * j2 + 1] + (1.f - lbv[2 * j2 + 1]) * sigm(za1);
        *(float2*)(qs + lt * 128 + lq * 16 + 2 * j2) = make_float2(qa0, qa1);
        *(float2*)(fsm + lt * 128 + lq * 16 + 2 * j2) = make_float2(f0, f1);
      }
      *(float4*)(is + lt * 32 + lq * 4) = make_float4(bflo(iv.x), bfhi(iv.x), bflo(iv.y), bfhi(iv.y));
    }
    __syncthreads();
    if (c0 + 32 < SEQ) {
      const bf16_t* row = p.u + (tokbase + c0 + 32 + lt) * UE;
      q0 = *(const uint4*)(row + C_QA + h * 128 + lq * 16);
      q1 = *(const uint4*)(row + C_QA + h * 128 + lq * 16 + 8);
      z0 = *(const uint4*)(row + C_FA + h * 128 + lq * 16);
      z1 = *(const uint4*)(row + C_FA + h * 128 + lq * 16 + 8);
      iv = *(const uint2*)(row + C_IA + h * 128 + vq * 32 + lq * 4);
    }
    float2 i2n = *(const float2*)(is + 2 * vp);
    float4 fan = *(const float4*)(fsm + k0), fbn = *(const float4*)(fsm + k0 + 4);
    float4 qan = *(const float4*)(qs + k0), qbn = *(const float4*)(qs + k0 + 4);
    for (int t0 = 0; t0 < 32; t0 += 8) {
#pragma unroll 4
      for (int tt = 0; tt < 8; ++tt) {
        const int t = t0 + tt;
        const float2 i2 = i2n;
        const float4 fa = fan, fb = fbn, qa = qan, qb = qbn;
        {
          const int tn = (t + 1 < 32) ? (t + 1) : 31;
          i2n = *(const float2*)(is + tn * 32 + 2 * vp);
          fan = *(const float4*)(fsm + tn * 128 + k0); fbn = *(const float4*)(fsm + tn * 128 + k0 + 4);
          qan = *(const float4*)(qs + tn * 128 + k0); qbn = *(const float4*)(qs + tn * 128 + k0 + 4);
        }
        const float f[8] = {fa.x, fa.y, fa.z, fa.w, fb.x, fb.y, fb.z, fb.w};
        const float q[8] = {qa.x, qa.y, qa.z, qa.w, qb.x, qb.y, qb.z, qb.w};
        const f32x2v iv = (f32x2v){i2.x, i2.y};
        f32x2v o01 = (f32x2v){0.f, 0.f};
#pragma unroll
        for (int j = 0; j < 8; ++j) {
          S01[j] = f[j] * (S01[j] - iv) + iv;
          o01 = q[j] * S01[j] + o01;
        }
        const float o0 = o01.x, o1 = o01.y;
        pb[((tt * 4 + vpl) * 2 + 0) * 16 + ksl] = o0;
        pb[((tt * 4 + vpl) * 2 + 1) * 16 + ksl] = o1;
      }
      {
        const float4* rp = (const float4*)(pb + rl * 16);
        const float4 r0 = rp[0], r1 = rp[1], r2 = rp[2], r3 = rp[3];
        const float sum = ((r0.x + r0.y) + (r0.z + r0.w)) + ((r1.x + r1.y) + (r1.z + r1.w)) +
                          (((r2.x + r2.y) + (r2.z + r2.w)) + ((r3.x + r3.y) + (r3.z + r3.w)));
        ob[(t0 + (rl >> 3)) * 32 + 2 * (wid4 + ((rl >> 1) & 3)) + (rl & 1)] = sum;
      }
    }
    __syncthreads();
    {
      float4 ov = *(const float4*)(ob + lt * 32 + lq * 4);
      *(float4*)(p.oraw + (tokbase + c0 + lt) * 512 + h * 128 + vq * 32 + lq * 4) = ov;
    }
  }
  __syncthreads();
}

using f16x8 = __attribute__((ext_vector_type(8))) _Float16;
__device__ __forceinline__ unsigned short f2h(float f) {
  _Float16 hv = (_Float16)f;
  return __builtin_bit_cast(unsigned short, hv);
}
__device__ __forceinline__ float fast_tanh(float x) { return 1.f - 2.f * __builtin_amdgcn_rcpf(1.f + __expf(2.f * x)); }
__device__ __forceinline__ float fast_softplus(float x) { return fmaxf(x, 0.f) + __logf(1.f + __expf(-fabsf(x))); }

__device__ void rwkv_item(const Params& p, int e, int item, char* smem) {
  const int tid = otid(), lane = tid & 63, wid = tid >> 6;
  const int fr = lane & 15, fq = lane >> 4;
  const int b = item >> 3, h = item & 7;
  float* rsA = (float*)smem;
  float* kraw = (float*)(smem + 4096);
  float* yb = kraw;
  float* vs = (float*)(smem + 8192);
  float* pre_w = (float*)(smem + 12288);
  float* pre_a = (float*)(smem + 16384);
  float* pre_v = (float*)(smem + 20480);
  bf16_t* At = (bf16_t*)(smem + 12288);
  bf16_t* Rt = At + 16 * 72;
  bf16_t* Bt = Rt + 16 * 72;
  bf16_t* Kt = Bt + 16 * 72;
  bf16_t* BKT = (bf16_t*)(smem + 12288 + 9216);
  bf16_t* VmT = BKT + 64 * 40;
  float* gL = (float*)(smem + 12288 + 9216 + 5120 + 3072);
  float* ldsum = (float*)(smem + 29952);
  float* cbs = (float*)(smem + 30976);
  bf16_t* S0b = (bf16_t*)(smem + 31040);
  char* wp = smem + 40256 + wid * 4864;
  float* Nt = (float*)wp;
  bf16_t* MT2 = (bf16_t*)(wp + 1024);
  bf16_t* MakT = (bf16_t*)(wp + 2304);
  float* Pbuf = (float*)(wp + 3584);
  bf16_t* L1b = (bf16_t*)(smem + 40256);
  const size_t tokbase = (size_t)b * SEQ;
  const float* mu = p.b_mu + (size_t)e * 5 * 512;
  bf16x8 w2f[2], a2f[2], v2f;
  {
    const int lcg = h * 64 + wid * 16 + fr;
#pragma unroll
    for (int ks = 0; ks < 2; ++ks)
#pragma unroll
      for (int i = 0; i < 8; ++i) {
        w2f[ks][i] = (short)f2bf(p.b_w2[(size_t)e * 64 * 512 + (size_t)(ks * 32 + fq * 8 + i) * 512 + lcg]);
        a2f[ks][i] = (short)f2bf(p.b_a2[(size_t)e * 64 * 512 + (size_t)(ks * 32 + fq * 8 + i) * 512 + lcg]);
      }
#pragma unroll
    for (int i = 0; i < 8; ++i)
      v2f[i] = (e >= 1) ? (short)f2bf(p.b_v2[(size_t)(e - 1) * 32 * 512 + (size_t)(fq * 8 + i) * 512 + lcg]) : (short)0;
  }
  const int bch = tid & 63, btg = tid >> 6, bcg = h * 64 + bch;
  const float w0 = p.b_w0[e * 512 + bcg], a0 = p.b_a0[e * 512 + bcg], kkc = p.b_kk[e * 512 + bcg],
              kac = p.b_ka[e * 512 + bcg], rkc = p.b_rk[e * 512 + bcg];
  const float v0c = (e >= 1) ? p.b_v0[(e - 1) * 512 + bcg] : 0.f;
  const int at = tid >> 4, aq = tid & 15;
  float* cst = (float*)(smem + 59712);
  float* gLm = (float*)(smem + 60992);
  float* gm = (float*)(smem + 61248);
  float* kkcs = (float*)(smem + 61504);
  float* kss = (float*)(smem + 61760);
  if (tid < 64) {
    const int cgj = h * 64 + tid;
    cst[tid] = mu[0 * 512 + cgj];
    cst[64 + tid] = mu[1 * 512 + cgj];
    cst[128 + tid] = mu[2 * 512 + cgj];
    cst[192 + tid] = p.b_gng[e * 512 + cgj];
    cst[256 + tid] = p.b_gnb[e * 512 + cgj];
    kkcs[tid] = p.b_kk[e * 512 + cgj];
  }
  f32x4 Sacc[4];
#pragma unroll
  for (int nt = 0; nt < 4; ++nt) Sacc[nt] = (f32x4){0.f, 0.f, 0.f, 0.f};

  uint2 rc, kc, vc, rp, kp, vpv, gnx;
  unsigned zc[5], zp[5];
  unsigned short vfn[4] = {0, 0, 0, 0};
  auto load_chunk = [&](int c0) {
    const int tg = c0 + at;
    const bf16_t* row = p.u + (tokbase + tg) * UE;
    const bf16_t* prow = row - UE;
    const bool hp = (tg > 0);
    rc = *(const uint2*)(row + C_RB + h * 64 + aq * 4);
    kc = *(const uint2*)(row + C_KB + h * 64 + aq * 4);
    vc = *(const uint2*)(row + C_VB + h * 64 + aq * 4);
    gnx = *(const uint2*)(row + C_GB + h * 64 + aq * 4);
    rp = make_uint2(0, 0); kp = make_uint2(0, 0); vpv = make_uint2(0, 0);
    if (hp) {
      rp = *(const uint2*)(prow + C_RB + h * 64 + aq * 4);
      kp = *(const uint2*)(prow + C_KB + h * 64 + aq * 4);
      vpv = *(const uint2*)(prow + C_VB + h * 64 + aq * 4);
    }
#pragma unroll
    for (int i = 0; i < 5; ++i) {
      zc[i] = *(const unsigned*)(row + C_ZC + aq * 10 + 2 * i);
      zp[i] = hp ? *(const unsigned*)(prow + C_ZP + aq * 10 + 2 * i) : 0u;
    }
    if (e >= 1) {
#pragma unroll
      for (int i = 0; i < 4; ++i) vfn[i] = p.vfirst[(tokbase + c0 + btg * 4 + i) * 512 + bcg];
    }
  };
  load_chunk(0);
  __syncthreads();

  for (int c0 = 0; c0 < SEQ; c0 += 16) {
    uint2 gcur = gnx;
    unsigned short vfc[4] = {vfn[0], vfn[1], vfn[2], vfn[3]};
    {
      int tA = tid; asm volatile("" : "+v"(tA));
      const int at = tA >> 4, aq = tA & 15;
      unsigned rca[2] = {rc.x, rc.y}, kca[2] = {kc.x, kc.y}, vca[2] = {vc.x, vc.y};
      unsigned rpa[2] = {rp.x, rp.y}, kpa[2] = {kp.x, kp.y}, vpa[2] = {vpv.x, vpv.y};
      float ro[4], ko[4], vo[4];
      const float4 mr4 = *(const float4*)(cst + aq * 4), mk4 = *(const float4*)(cst + 64 + aq * 4),
                   mv4 = *(const float4*)(cst + 128 + aq * 4);
      const float mur[4] = {mr4.x, mr4.y, mr4.z, mr4.w}, muk[4] = {mk4.x, mk4.y, mk4.z, mk4.w},
                  muv[4] = {mv4.x, mv4.y, mv4.z, mv4.w};
#pragma unroll
      for (int j2 = 0; j2 < 2; ++j2) {
        float r0 = bflo(rca[j2]), r1 = bflo(rpa[j2]), r2 = bfhi(rca[j2]), r3 = bfhi(rpa[j2]);
        float k0f = bflo(kca[j2]), k1f = bflo(kpa[j2]), k2f = bfhi(kca[j2]), k3f = bfhi(kpa[j2]);
        float v0f = bflo(vca[j2]), v1f = bflo(vpa[j2]), v2f2 = bfhi(vca[j2]), v3f = bfhi(vpa[j2]);
        ro[2 * j2] = r0 + (r1 - r0) * mur[2 * j2];
        ro[2 * j2 + 1] = r2 + (r3 - r2) * mur[2 * j2 + 1];
        ko[2 * j2] = k0f + (k1f - k0f) * muk[2 * j2];
        ko[2 * j2 + 1] = k2f + (k3f - k2f) * muk[2 * j2 + 1];
        vo[2 * j2] = v0f + (v1f - v0f) * muv[2 * j2];
        vo[2 * j2 + 1] = v2f2 + (v3f - v2f2) * muv[2 * j2 + 1];
      }
      *(float4*)(rsA + at * 64 + aq * 4) = make_float4(ro[0], ro[1], ro[2], ro[3]);
      *(float4*)(kraw + at * 64 + aq * 4) = make_float4(ko[0], ko[1], ko[2], ko[3]);
      {
        const float4 kc4 = *(const float4*)(kkcs + aq * 4);
        const float k0 = ko[0] * kc4.x, k1 = ko[1] * kc4.y, k2 = ko[2] * kc4.z, k3 = ko[3] * kc4.w;
        const float ssr = red16(k0 * k0 + k1 * k1 + k2 * k2 + k3 * k3);
        if (aq == 0) kss[at] = ssr;
      }
      *(float4*)(vs + at * 64 + aq * 4) = make_float4(vo[0], vo[1], vo[2], vo[3]);
#pragma unroll
      for (int i = 0; i < 5; ++i) {
        const int j = aq * 10 + 2 * i;
        float x0 = bflo(zc[i]) + bflo(zp[i]);
        float x1 = bfhi(zc[i]) + bfhi(zp[i]);
        if (j < 64) { x0 = fast_tanh(x0); x1 = fast_tanh(x1); }
        *(unsigned*)(L1b + at * 168 + j) = pack2(x0, x1);
      }
    }
    __syncthreads();
    {
      int tL = tid; asm volatile("" : "+v"(tL));
      const int fr = tL & 15, fq = (tL & 63) >> 4;
      f32x4 accw = {0.f, 0.f, 0.f, 0.f}, acca = {0.f, 0.f, 0.f, 0.f}, accv = {0.f, 0.f, 0.f, 0.f};
#pragma unroll
      for (int ks = 0; ks < 2; ++ks) {
        bf16x8 af = *(const bf16x8*)(L1b + fr * 168 + ks * 32 + fq * 8);
        accw = __builtin_amdgcn_mfma_f32_16x16x32_bf16(af, w2f[ks], accw, 0, 0, 0);
        bf16x8 ag = *(const bf16x8*)(L1b + fr * 168 + 64 + ks * 32 + fq * 8);
        acca = __builtin_amdgcn_mfma_f32_16x16x32_bf16(ag, a2f[ks], acca, 0, 0, 0);
      }
      if (e >= 1) {
        bf16x8 ah = *(const bf16x8*)(L1b + fr * 168 + 128 + fq * 8);
        accv = __builtin_amdgcn_mfma_f32_16x16x32_bf16(ah, v2f, accv, 0, 0, 0);
      }
#pragma unroll
      for (int i = 0; i < 4; ++i) {
        pre_w[(4 * fq + i) * 64 + wid * 16 + fr] = accw[i];
        pre_a[(4 * fq + i) * 64 + wid * 16 + fr] = acca[i];
        pre_v[(4 * fq + i) * 64 + wid * 16 + fr] = accv[i];
      }
    }
    __syncthreads();
    float qa[4], qb[4], qk[4], qr[4], qv[4], qld[4];
    {
      int tB = tid; asm volatile("" : "+v"(tB));
      const int bch = tB & 63;
      float lsum = 0.f;
#pragma unroll
      for (int i = 0; i < 4; ++i) {
        const int t = btg * 4 + i;
        const size_t tok = tokbase + c0 + t;
        const float wpre = w0 + pre_w[t * 64 + bch];
        const float wlog = -fast_softplus(-wpre) - 0.5f;
        const float ld = -__expf(wlog);
        const float icl = sigm(a0 + pre_a[t * 64 + bch]);
        const float k = kraw[t * 64 + bch];
        const float r = rsA[t * 64 + bch];
        float vv = vs[t * 64 + bch];
        if (e >= 1) {
          const float vg = sigm(v0c + pre_v[t * 64 + bch]);
          const float vf = bf2f(vfc[i]);
          vv = vv + (vf - vv) * vg;
        } else {
          p.vfirst[tok * 512 + bcg] = f2bf(vv);
        }
        const float kkv = k * kkc;
        const float ss = kss[t];
        const float kkn = kkv * rsqrtf(fmaxf(ss, 1e-24f));
        const float kh = k * (1.f + (icl - 1.f) * kac);
        rsA[t * 64 + bch] = r * kh * rkc;
        qa[i] = -kkn;
        qb[i] = kkn * icl;
        qk[i] = kh;
        qr[i] = r;
        qv[i] = vv;
        qld[i] = ld;
        lsum += ld;
        vs[t * 64 + bch] = vv;
      }
      ldsum[btg * 64 + bch] = lsum;
    }
    __syncthreads();
    {
      int tB = tid; asm volatile("" : "+v"(tB));
      const int bch = tB & 63;
      float c = 0.f;
      for (int g = 0; g < btg; ++g) c += ldsum[g * 64 + bch];
      const float cref = ldsum[bch] + ldsum[64 + bch];
#pragma unroll
      for (int i = 0; i < 4; ++i) {
        const int t = btg * 4 + i;
        const float eprev = __expf(c - cref);
        c += qld[i];
        const float ecur = __expf(c - cref), einv = __expf(cref - c);
        At[t * 72 + bch] = f2h(qa[i] * eprev);
        Rt[t * 72 + bch] = f2h(qr[i] * ecur);
        const unsigned short bb = f2h(qb[i] * einv), kb = f2h(qk[i] * einv);
        Bt[t * 72 + bch] = bb;
        Kt[t * 72 + bch] = kb;
        BKT[bch * 40 + t] = bb;
        BKT[bch * 40 + 16 + t] = kb;
        VmT[bch * 24 + t] = f2h(qv[i]);
      }
      if (btg == 3) {
        gL[bch] = __expf(c);
        gLm[bch] = __expf(c - cref);
        gm[bch] = __expf(cref);
      }
    }
    __syncthreads();
    if (c0 + 16 < SEQ) load_chunk(c0 + 16);
    {
      int tC = tid; asm volatile("" : "+v"(tC));
      const int lane = tC & 63, fr = tC & 15, fq = (tC & 63) >> 4;
      *(uint2*)(MakT + (lane >> 2) * 40 + (lane & 3) * 4) = make_uint2(0u, 0u);
#pragma unroll
      for (int nt = 0; nt < 4; ++nt) {
        const float gmk = gm[nt * 16 + fr];
#pragma unroll
        for (int i = 0; i < 4; ++i) S0b[(wid * 16 + 4 * fq + i) * 72 + nt * 16 + fr] = f2h(Sacc[nt][i] * gmk);
      }
      f16x8 aF[2], rF[2], bF[2], kF[2], sF[2];
#pragma unroll
      for (int ks = 0; ks < 2; ++ks) {
        aF[ks] = *(const f16x8*)(At + fr * 72 + ks * 32 + fq * 8);
        rF[ks] = *(const f16x8*)(Rt + fr * 72 + ks * 32 + fq * 8);
        bF[ks] = *(const f16x8*)(Bt + fr * 72 + ks * 32 + fq * 8);
        kF[ks] = *(const f16x8*)(Kt + fr * 72 + ks * 32 + fq * 8);
        sF[ks] = *(const f16x8*)(S0b + (wid * 16 + fr) * 72 + ks * 32 + fq * 8);
      }
      const f32x4 zz = {0.f, 0.f, 0.f, 0.f};
      f32x4 qab = __builtin_amdgcn_mfma_f32_16x16x32_f16(aF[0], bF[0], zz, 0, 0, 0);
      qab = __builtin_amdgcn_mfma_f32_16x16x32_f16(aF[1], bF[1], qab, 0, 0, 0);
      f32x4 qak = __builtin_amdgcn_mfma_f32_16x16x32_f16(aF[0], kF[0], zz, 0, 0, 0);
      qak = __builtin_amdgcn_mfma_f32_16x16x32_f16(aF[1], kF[1], qak, 0, 0, 0);
      f32x4 qrb = __builtin_amdgcn_mfma_f32_16x16x32_f16(rF[0], bF[0], zz, 0, 0, 0);
      qrb = __builtin_amdgcn_mfma_f32_16x16x32_f16(rF[1], bF[1], qrb, 0, 0, 0);
      f32x4 qrk = __builtin_amdgcn_mfma_f32_16x16x32_f16(rF[0], kF[0], zz, 0, 0, 0);
      qrk = __builtin_amdgcn_mfma_f32_16x16x32_f16(rF[1], kF[1], qrk, 0, 0, 0);
      f32x4 x1 = __builtin_amdgcn_mfma_f32_16x16x32_f16(aF[0], sF[0], zz, 0, 0, 0);
      x1 = __builtin_amdgcn_mfma_f32_16x16x32_f16(aF[1], sF[1], x1, 0, 0, 0);
      f32x4 x2 = __builtin_amdgcn_mfma_f32_16x16x32_f16(rF[0], sF[0], zz, 0, 0, 0);
      x2 = __builtin_amdgcn_mfma_f32_16x16x32_f16(rF[1], sF[1], x2, 0, 0, 0);
      *(float4*)(Nt + fr * 16 + 4 * fq) = make_float4((fr < 4 * fq + 0) ? qab[0] : 0.f, (fr < 4 * fq + 1) ? qab[1] : 0.f,
                                                       (fr < 4 * fq + 2) ? qab[2] : 0.f, (fr < 4 * fq + 3) ? qab[3] : 0.f);
#pragma unroll
      for (int i = 0; i < 4; ++i) {
        const int t = 4 * fq + i, j = fr;
        MakT[t * 40 + 16 + j] = f2h((j < t) ? qak[i] : 0.f);
        MT2[t * 40 + j] = f2h((j <= t) ? qrb[i] : 0.f);
        MT2[t * 40 + 16 + j] = f2h((j <= t) ? qrk[i] : 0.f);
      }
      __builtin_amdgcn_sched_barrier(0);
      f16x8 vmF = (f16x8){0, 0, 0, 0, 0, 0, 0, 0};
      if (fq >= 2) vmF = *(const f16x8*)(VmT + (wid * 16 + fr) * 24 + (fq - 2) * 8);
      const f16x8 makF = *(const f16x8*)(MakT + fr * 40 + fq * 8);
      x1 = __builtin_amdgcn_mfma_f32_16x16x32_f16(makF, vmF, x1, 0, 0, 0);
      *(float4*)(Pbuf + fr * 20 + 4 * fq) = make_float4(x1[0], x1[1], x1[2], x1[3]);
      __builtin_amdgcn_sched_barrier(0);
      float P[16];
#pragma unroll
      for (int q4 = 0; q4 < 4; ++q4) {
        const float4 pv4 = *(const float4*)(Pbuf + fr * 20 + 4 * q4);
        P[4 * q4 + 0] = pv4.x; P[4 * q4 + 1] = pv4.y; P[4 * q4 + 2] = pv4.z; P[4 * q4 + 3] = pv4.w;
      }
#pragma unroll
      for (int j = 0; j < 15; ++j) {
        float ncol[16];
#pragma unroll
        for (int q4 = (j + 1) / 4; q4 < 4; ++q4) {
          const float4 n4 = *(const float4*)(Nt + j * 16 + 4 * q4);
          ncol[4 * q4 + 0] = n4.x; ncol[4 * q4 + 1] = n4.y; ncol[4 * q4 + 2] = n4.z; ncol[4 * q4 + 3] = n4.w;
        }
        const float pj = P[j];
#pragma unroll
        for (int t = j + 1; t < 16; ++t) P[t] = fmaf(pj, ncol[t], P[t]);
      }
      __builtin_amdgcn_sched_barrier(0);
      f16x8 pvF = vmF;
      if (fq == 0) {
#pragma unroll
        for (int i = 0; i < 8; ++i) pvF[i] = (_Float16)P[i];
      } else if (fq == 1) {
#pragma unroll
        for (int i = 0; i < 8; ++i) pvF[i] = (_Float16)P[8 + i];
      }
      const f16x8 mt2F = *(const f16x8*)(MT2 + fr * 40 + fq * 8);
      x2 = __builtin_amdgcn_mfma_f32_16x16x32_f16(mt2F, pvF, x2, 0, 0, 0);
#pragma unroll
      for (int i = 0; i < 4; ++i) yb[(4 * fq + i) * 64 + wid * 16 + fr] = x2[i];
      __builtin_amdgcn_sched_barrier(0);
#pragma unroll
      for (int nt = 0; nt < 4; ++nt) {
        const f16x8 bkF = *(const f16x8*)(BKT + (nt * 16 + fr) * 40 + fq * 8);
        const f32x4 dS = __builtin_amdgcn_mfma_f32_16x16x32_f16(pvF, bkF, zz, 0, 0, 0);
        const float g = gL[nt * 16 + fr], g2 = gLm[nt * 16 + fr];
#pragma unroll
        for (int i = 0; i < 4; ++i) Sacc[nt][i] = Sacc[nt][i] * g + dS[i] * g2;
      }
    }
    __syncthreads();
    {
      int tD = tid; asm volatile("" : "+v"(tD));
      const int at = tD >> 4, aq = tD & 15;
      const size_t tok = tokbase + c0 + at;
      const float4 y4 = *(const float4*)(yb + at * 64 + aq * 4);
      const float4 v4 = *(const float4*)(vs + at * 64 + aq * 4);
      const float yv[4] = {y4.x, y4.y, y4.z, y4.w};
      const float vv4[4] = {v4.x, v4.y, v4.z, v4.w};
      const float mean = red16(yv[0] + yv[1] + yv[2] + yv[3]) * (1.f / 64.f);
      float q = 0.f;
#pragma unroll
      for (int j = 0; j < 4; ++j) { float d = yv[j] - mean; q += d * d; }
      q = red16(q);
      const float rstd = rsqrtf(q * (1.f / 64.f) + 64e-5f);
      const float4 pc4 = *(const float4*)(rsA + at * 64 + aq * 4);
      const float cb = red16(pc4.x + pc4.y + pc4.z + pc4.w);
      const float4 gg4 = *(const float4*)(cst + 192 + aq * 4), gb4 = *(const float4*)(cst + 256 + aq * 4);
      const float gng[4] = {gg4.x, gg4.y, gg4.z, gg4.w}, gnb[4] = {gb4.x, gb4.y, gb4.z, gb4.w};
      const float g[4] = {bflo(gcur.x), bfhi(gcur.x), bflo(gcur.y), bfhi(gcur.y)};
      float o[4];
#pragma unroll
      for (int j = 0; j < 4; ++j) {
        float yn = (yv[j] - mean) * rstd * gng[j] + gnb[j] + cb * vv4[j];
        o[j] = yn * silu(g[j]);
      }
      uint2 ov;
      ov.x = pack2(o[0], o[1]);
      ov.y = pack2(o[2], o[3]);
      *(uint2*)(p.mixb + tok * 512 + h * 64 + aq * 4) = ov;
    }
    __syncthreads();
  }
}


__device__ void phase_mixers(const Params& p, int e, char* smem) {
  const int b = blockIdx.x;
  if (gridDim.x == 512) {
    if (b < 128) { for (int rr = 0; rr < REP_R; ++rr) rwkv_item(p, e, b, smem); }
    else if (b < 256) { for (int rr = 0; rr < REP_H; ++rr) hgrn2_item(p, e, b - 128, smem); }
    else if (b >= 384) { for (int rr = 0; rr < REP_H; ++rr) hgrn2_item(p, e, b - 256, smem); }
  } else {
    for (int item = blockIdx.x; item < 384; item += gridDim.x) {
      if (item < 256) { for (int rr = 0; rr < REP_H; ++rr) hgrn2_item(p, e, item, smem); }
      else { for (int rr = 0; rr < REP_R; ++rr) rwkv_item(p, e, item - 256, smem); }
    }
  }
}

__device__ void phase_hpost(const Params& p, int e) {
  const int lane = otid() & 63, wid = otid() >> 6;
  const int nw = gridDim.x * 4;
  const int c = lane * 8;
  float ng[8];
#pragma unroll
  for (int j = 0; j < 8; ++j) ng[j] = p.a_ng[e * 512 + c + j];
  for (int tok0 = (blockIdx.x * 4 + wid) * 4; tok0 < NTOK; tok0 += nw * 4) {
    float4 o0[4], o1[4];
    uint4 gv[4];
#pragma unroll
    for (int rr = 0; rr < 4; ++rr) {
      const float* o = p.oraw + (size_t)(tok0 + rr) * 512 + c;
      o0[rr] = *(const float4*)o;
      o1[rr] = *(const float4*)(o + 4);
      gv[rr] = *(const uint4*)(p.u + (size_t)(tok0 + rr) * UE + C_GA + c);
    }
#pragma unroll
    for (int rr = 0; rr < 4; ++rr) {
      float ov[8] = {o0[rr].x, o0[rr].y, o0[rr].z, o0[rr].w, o1[rr].x, o1[rr].y, o1[rr].z, o1[rr].w};
      float ss = 0.f;
#pragma unroll
      for (int j = 0; j < 8; ++j) ss += ov[j] * ov[j];
#pragma unroll
      for (int m = 8; m >= 1; m >>= 1) ss += __shfl_xor(ss, m);
      const float rs = rsqrtf(ss * (1.f / 128.f) + 1e-6f);
      unsigned ga[4] = {gv[rr].x, gv[rr].y, gv[rr].z, gv[rr].w};
      float r[8];
#pragma unroll
      for (int j = 0; j < 8; ++j) {
        float g = bf2f((unsigned short)((ga[j >> 1] >> ((j & 1) * 16)) & 0xffff));
        r[j] = ov[j] * rs * ng[j] * silu(g);
      }
      uint4 w;
      w.x = pack2(r[0], r[1]); w.y = pack2(r[2], r[3]); w.z = pack2(r[4], r[5]); w.w = pack2(r[6], r[7]);
      *(uint4*)(p.act + (size_t)(tok0 + rr) * DM + c) = w;
    }
  }
}

__device__ void phase_conv(const Params& p, int o) {
  const float* cw = p.od_cw + (size_t)o * 4 * 1024;
  const float* cbp = p.od_cb + (size_t)o * 1024;
  const int tid = otid();
  const int c = (tid & 127) * 8;
  float wt[4][8], bias[8];
#pragma unroll
  for (int j = 0; j < 8; ++j) {
    bias[j] = cbp[c + j];
#pragma unroll
    for (int w = 0; w < 4; ++w) wt[w][j] = cw[w * 1024 + c + j];
  }
  for (int tok = (int)blockIdx.x * 2 + (tid >> 7); tok < NTOK; tok += (int)gridDim.x * 2) {
    const int t = tok & (SEQ - 1);
    uint4 xv[4];
#pragma unroll
    for (int w = 0; w < 4; ++w) {
      xv[w] = make_uint4(0u, 0u, 0u, 0u);
      if (t + w - 3 >= 0) xv[w] = *(const uint4*)(p.u + (size_t)(tok + w - 3) * UO + c);
    }
    float acc[8];
#pragma unroll
    for (int j = 0; j < 8; ++j) acc[j] = bias[j];
#pragma unroll
    for (int w = 0; w < 4; ++w) {
      const unsigned xa[4] = {xv[w].x, xv[w].y, xv[w].z, xv[w].w};
#pragma unroll
      for (int j2 = 0; j2 < 4; ++j2) {
        acc[2 * j2] += wt[w][2 * j2] * bflo(xa[j2]);
        acc[2 * j2 + 1] += wt[w][2 * j2 + 1] * bfhi(xa[j2]);
      }
    }
    uint4 ov;
    ov.x = pack2(acc[0], acc[1]); ov.y = pack2(acc[2], acc[3]); ov.z = pack2(acc[4], acc[5]); ov.w = pack2(acc[6], acc[7]);
    *(uint4*)(p.act + (size_t)tok * DM + c) = ov;
  }
}

__device__ __forceinline__ float neg_expm1_fast(float x) {
  const float ser = -x * (1.f + x * (0.5f + x * (0.16666667f + x * 0.041666668f)));
  const float big = 1.f - __expf(x);
  return (x > -0.125f) ? ser : big;
}

__device__ void phase_gates(const Params& p, int o, char* smem) {
  const int ntiles = 4 * 256 * 4;
  const int lane = otid() & 63, wid = otid() >> 6, wr = wid >> 1, wc = wid & 1, fr = lane & 15, fq = lane >> 4;
  const int tpx = ntiles >> 3, nbx = gridDim.x >> 3, xcd = blockIdx.x & 7;
  for (int lt = (gridDim.x == 512) ? ((((blockIdx.x >> 3) & 31) << 1) + (blockIdx.x >> 8)) : (blockIdx.x >> 3); lt < tpx; lt += nbx) {
    const int t = xcd * tpx + lt;
    const int g = t >> 10, r = t & 1023, m0 = (r >> 2) * 128, ntile = r & 3;
    f32x4 acc[4][4];
    GEMM_SLOTS_DECL
    gemm_mainloop(p.act + (size_t)m0 * DM + g * 256, DM, p.wg + (size_t)(o * 4 + g) * 512 * 256 + (size_t)ntile * 128 * 256,
                  256, 256, acc, smem, p.act, DM, 1 << 20, GEMM_SLOTS_ARGS, false, nullptr, nullptr);
#pragma unroll
    for (int hf = 0; hf < 2; ++hf) {
      const int col = g * 256 + ntile * 64 + wc * 32 + hf * 16 + fq * 4;
      float4 ba = *(const float4*)(p.od_ba + o * 1024 + col);
      float4 bx = *(const float4*)(p.od_bx + o * 1024 + col);
      float4 lm = *(const float4*)(p.od_lam + o * 1024 + col);
      float bav[4] = {ba.x, ba.y, ba.z, ba.w}, bxv[4] = {bx.x, bx.y, bx.z, bx.w}, lmv[4] = {lm.x, lm.y, lm.z, lm.w};
      float spl[4];
#pragma unroll
      for (int j = 0; j < 4; ++j) spl[j] = fast_softplus(-lmv[j]);
#pragma unroll
      for (int mt = 0; mt < 4; ++mt) {
        const int m = m0 + wr * 64 + mt * 16 + fr;
        uint2 xv = *(const uint2*)(p.act + (size_t)m * DM + col);
        unsigned xa[2] = {xv.x, xv.y};
        float lav[4], uv[4];
#pragma unroll
        for (int j = 0; j < 4; ++j) {
          const float gr = sigm(acc[mt][hf * 2][j] + bav[j]);
          const float gi = sigm(acc[mt][hf * 2 + 1][j] + bxv[j]);
          const float la = bf2f(f2bf(-8.f * gr * spl[j]));
          const float xc = bf2f((unsigned short)((xa[j >> 1] >> ((j & 1) * 16)) & 0xffff));
          lav[j] = la;
          uv[j] = __builtin_amdgcn_sqrtf(neg_expm1_fast(2.f * la)) * gi * xc;
        }
        { uint2 lo; lo.x = pack2(lav[0], lav[1]); lo.y = pack2(lav[2], lav[3]); *(uint2*)(p.la + (size_t)m * DM + col) = lo; }
        uint2 uo;
        uo.x = pack2(uv[0], uv[1]);
        uo.y = pack2(uv[2], uv[3]);
        *(uint2*)(p.uin + (size_t)m * DM + col) = uo;
      }
    }
  }
}

__device__ void phase_scan(const Params& p, char* smem) {
  float* sL = (float*)smem;
  float* sH = sL + 1024;
  const int tid = otid(), cq = tid & 7, seg = tid >> 3;
  for (int item = blockIdx.x; item < 512; item += gridDim.x) {
    const int b = item >> 5, c = (item & 31) * 32 + cq * 4;
    const size_t base = ((size_t)b * SEQ + seg * 64) * DM + c;
    float L[4] = {0.f, 0.f, 0.f, 0.f}, h[4] = {0.f, 0.f, 0.f, 0.f};
#pragma unroll 8
    for (int t = 0; t < 64; ++t) {
      const uint2 lab = *(const uint2*)(p.la + base + (size_t)t * DM);
      const float4 la = make_float4(bflo(lab.x), bfhi(lab.x), bflo(lab.y), bfhi(lab.y));
      const uint2 uu = *(const uint2*)(p.uin + base + (size_t)t * DM);
      h[0] = __expf(la.x) * h[0] + bflo(uu.x);
      h[1] = __expf(la.y) * h[1] + bfhi(uu.x);
      h[2] = __expf(la.z) * h[2] + bflo(uu.y);
      h[3] = __expf(la.w) * h[3] + bfhi(uu.y);
      L[0] += la.x; L[1] += la.y; L[2] += la.z; L[3] += la.w;
    }
    *(float4*)(sL + seg * 32 + cq * 4) = make_float4(L[0], L[1], L[2], L[3]);
    *(float4*)(sH + seg * 32 + cq * 4) = make_float4(h[0], h[1], h[2], h[3]);
    __syncthreads();
    float hc[4] = {0.f, 0.f, 0.f, 0.f};
    for (int s2 = 0; s2 < seg; ++s2) {
      const float4 l4 = *(const float4*)(sL + s2 * 32 + cq * 4);
      const float4 h4 = *(const float4*)(sH + s2 * 32 + cq * 4);
      hc[0] = __expf(l4.x) * hc[0] + h4.x;
      hc[1] = __expf(l4.y) * hc[1] + h4.y;
      hc[2] = __expf(l4.z) * hc[2] + h4.z;
      hc[3] = __expf(l4.w) * hc[3] + h4.w;
    }
    h[0] = hc[0]; h[1] = hc[1]; h[2] = hc[2]; h[3] = hc[3];
    const size_t gbase = ((size_t)b * SEQ + seg * 64) * UO + 1024 + c;
#pragma unroll 8
    for (int t = 0; t < 64; ++t) {
      const uint2 lab = *(const uint2*)(p.la + base + (size_t)t * DM);
      const float4 la = make_float4(bflo(lab.x), bfhi(lab.x), bflo(lab.y), bfhi(lab.y));
      const uint2 uu = *(const uint2*)(p.uin + base + (size_t)t * DM);
      const uint2 gg = *(const uint2*)(p.u + gbase + (size_t)t * UO);
      h[0] = __expf(la.x) * h[0] + bflo(uu.x);
      h[1] = __expf(la.y) * h[1] + bfhi(uu.x);
      h[2] = __expf(la.z) * h[2] + bflo(uu.y);
      h[3] = __expf(la.w) * h[3] + bfhi(uu.y);
      uint2 o;
      o.x = pack2(h[0] * silu(bflo(gg.x)), h[1] * silu(bfhi(gg.x)));
      o.y = pack2(h[2] * silu(bflo(gg.y)), h[3] * silu(bfhi(gg.y)));
      *(uint2*)(p.act + base + (size_t)t * DM) = o;
    }
    __syncthreads();
  }
}


#define XB_TMO      128
#define XB_XCNT(j)  (256  + 64 * (j))
#define XB_XSUB(j)  (1280 + 64 * (j))
#define XB_XGEN(j)  (2304 + 64 * (j))
#define XB_TOP      3328
#define XB_TOPGEN   3392
#define XCD_BAR_WORDS 3456
#define XB_SPIN_CAP (1u << 22)
#define LAS __attribute__((address_space(3)))
__device__ __forceinline__ unsigned xb_ld(unsigned* p) { return __hip_atomic_load(p, __ATOMIC_RELAXED, __HIP_MEMORY_SCOPE_AGENT); }
__device__ __forceinline__ unsigned xb_add(unsigned* p, unsigned v) { return __hip_atomic_fetch_add(p, v, __ATOMIC_RELAXED, __HIP_MEMORY_SCOPE_AGENT); }
__device__ __forceinline__ unsigned xb_xcc_id() { return (unsigned)__builtin_amdgcn_s_getreg((3 << 11) | 20) & 0xFu; }
#define XB_SPIN(cond, bar) do { unsigned _sp = 0; while (cond) { __builtin_amdgcn_s_sleep(1); \
    if ((++_sp & 255u) == 0u) { if (xb_ld(&(bar)[XB_TMO])) break; if (_sp > XB_SPIN_CAP) { atomicAdd(&(bar)[XB_TMO], 1u); break; } } } } while (0)
struct XcdBarrier { unsigned* bar; unsigned x; volatile LAS unsigned* st; unsigned total; };
__device__ __forceinline__ XcdBarrier xcd_barrier_post(unsigned* bar, volatile LAS unsigned* st, unsigned total) {
  XcdBarrier b; b.bar = bar; b.x = xb_xcc_id(); b.st = st; b.total = total;
  if (threadIdx.x == 0) (void)xb_add(&bar[XB_XCNT(b.x)], 1u);
  return b;
}
__device__ __forceinline__ void xcd_barrier_complete(unsigned* bar, unsigned x, unsigned& nloc, unsigned& nx, unsigned G) {
  unsigned sum, cnt, mine, sp = 0u;
  for (;;) {
    sum = 0u; cnt = 0u; mine = 0u;
#pragma unroll
    for (unsigned j = 0; j < 16; ++j) { const unsigned c = xb_ld(&bar[XB_XCNT(j)]); sum += c; cnt += (c > 0u) ? 1u : 0u; mine = (j == x) ? c : mine; }
    if (sum == G) break;
    __builtin_amdgcn_s_sleep(1);
    if ((++sp & 255u) == 0u) { if (xb_ld(&bar[XB_TMO])) break; if (sp > XB_SPIN_CAP) { atomicAdd(&bar[XB_TMO], 1u); break; } }
  }
  nloc = mine > 0u ? mine : 1u; nx = cnt > 0u ? cnt : 1u;
}
__device__ __forceinline__ void xcd_barrier(const XcdBarrier& b) {
  asm volatile("s_waitcnt vmcnt(0)" ::: "memory");
  __syncthreads();
  if (threadIdx.x == 0) {
    unsigned* bar = b.bar;
    asm volatile("" : "+v"(bar));
    __builtin_amdgcn_s_waitcnt(0);
    unsigned nloc = b.st[0], nx = b.st[1];
    if (nloc == 0u) { xcd_barrier_complete(bar, b.x, nloc, nx, b.total); b.st[0] = nloc; b.st[1] = nx; }
    const unsigned old = xb_add(&bar[XB_XSUB(b.x)], 1u);
    const unsigned gen = old / nloc;
    if (old + 1u == (gen + 1u) * nloc) {
      __builtin_amdgcn_fence(__ATOMIC_RELEASE, "agent");
      asm volatile("s_waitcnt vmcnt(0)" ::: "memory");
      const unsigned og = xb_add(&bar[XB_TOP], 1u);
      const unsigned tg = og / nx;
      if (og + 1u == (tg + 1u) * nx) xb_add(&bar[XB_TOPGEN], 1u);
      else XB_SPIN(xb_ld(&bar[XB_TOPGEN]) == tg, bar);
      __builtin_amdgcn_fence(__ATOMIC_ACQUIRE, "agent");
      xb_add(&bar[XB_XGEN(b.x)], 1u);
      asm volatile("s_waitcnt vmcnt(0)" ::: "memory");
    } else {
      XB_SPIN(xb_ld(&bar[XB_XGEN(b.x)]) == gen, bar);
      __builtin_amdgcn_fence(__ATOMIC_ACQUIRE, "agent");
      asm volatile("s_waitcnt vmcnt(0)" ::: "memory");
    }
  }
  __syncthreads();
}

__device__ __forceinline__ void sub_barrier(unsigned* cnt, unsigned target) {
  asm volatile("s_waitcnt vmcnt(0)" ::: "memory");
  __syncthreads();
  if (threadIdx.x == 0) {
    __builtin_amdgcn_fence(__ATOMIC_RELEASE, "agent");
    asm volatile("s_waitcnt vmcnt(0)" ::: "memory");
    (void)xb_add(cnt, 1u);
    unsigned sp = 0;
    while (xb_ld(cnt) < target) { __builtin_amdgcn_s_sleep(2); if (++sp > (1u << 26)) break; }
    __builtin_amdgcn_fence(__ATOMIC_ACQUIRE, "agent");
    asm volatile("s_waitcnt vmcnt(0)" ::: "memory");
  }
  __syncthreads();
}

__device__ void phase_mixers_overlap(const Params& p, int e, char* smem, const XcdBarrier& xb2) {
  const int b = blockIdx.x;
  if (b < 128) {
    rwkv_item(p, e, b, smem);
  } else {
    phase_gemm_in_range(p, p.wev_in + (size_t)e * UE * 1024, UE, 0, 12, 128, 384, smem);
    xcd_barrier(xb2);
    if (b < 256) hgrn2_item(p, e, b - 128, smem);
    else if (b >= 384) hgrn2_item(p, e, b - 256, smem);
    else phase_gemm_in_range(p, p.wev_in + (size_t)e * UE * 1024, UE, 12, 4, 256, 128, smem);
  }
}

__global__ void __launch_bounds__(NTHR, 2) __attribute__((amdgpu_num_vgpr(NVGPR_CAP))) mega_kernel(Params p) {
  __shared__ __attribute__((aligned(16))) char smem[SMEM_BYTES];
  cg::grid_group grid = cg::this_grid();
  __shared__ uint4 xb_words;
  if (threadIdx.x == 0) xb_words = make_uint4(0u, 0u, 0u, 0u);
  __syncthreads();
  XcdBarrier xb = xcd_barrier_post(p.bar, (volatile LAS unsigned*)&xb_words, gridDim.x);
  XcdBarrier xb2 = xb;
  xb2.bar = p.bar + XCD_BAR_WORDS; xb2.st = (volatile LAS unsigned*)&xb_words.z; xb2.total = 384u;
  if (gridDim.x == 512 && blockIdx.x >= 128 && threadIdx.x == 0) (void)xb_add(&xb2.bar[XB_XCNT(xb2.x)], 1u);
  for (int rep = 0; rep < REP_PRE; ++rep) {
  PH_PREP(phase_prep(p, smem);)
  if (p.never) grid.sync();
  xcd_barrier(xb);
  PH_H0(phase_h0(p);)
  xcd_barrier(xb);
  }
#pragma unroll 1
  for (int l = 0; l < 4; ++l) {
    const int idx = l >> 1;
    const bf16_t* wout;
    if ((l & 1) == 0) {
      if (gridDim.x == 512) {
        phase_gemm_in_range(p, p.wev_in + (size_t)idx * UE * 1024, UE, 16, 19, 0, 512, smem);
        xcd_barrier(xb);
        phase_mixers_overlap(p, idx, smem, xb2);
        xcd_barrier(xb);
      } else {
        phase_gemm_in(p, p.wev_in + (size_t)idx * UE * 1024, UE, UE, smem);
        xcd_barrier(xb);
        phase_mixers(p, idx, smem);
        xcd_barrier(xb);
      }
      for (int rep = 0; rep < REP_HP; ++rep) { PH_HPOST(phase_hpost(p, idx);)
      xcd_barrier(xb); }
      wout = p.wev_out + (size_t)idx * 1024 * 1024;
    } else {
      PH_GIN(phase_gemm_in(p, p.wod_in + (size_t)idx * 2048 * 1024, UO, UO, smem);)
      xcd_barrier(xb);
      for (int rep = 0; rep < REP_ODD; ++rep) { PH_CONV(phase_conv(p, idx);)
      xcd_barrier(xb);
      PH_GATES(phase_gates(p, idx, smem);)
      xcd_barrier(xb);
      PH_SCAN(phase_scan(p, smem);)
      xcd_barrier(xb); }
      wout = p.wod_out + (size_t)idx * 1024 * 1024;
    }
    PH_GOUT(phase_gemm_out(p, l, wout, smem, (l & 1) == 0);)
    xcd_barrier(xb);
    PH_LN(phase_ln(p, l);)
    if (l < 3) xcd_barrier(xb);
  }
}

extern "C" void kernel_launch(void* const* d_in, const int* in_sizes, int n_in, void* d_out, int out_size, void* d_ws,
                              size_t ws_size, hipStream_t stream) {
  static int grid_blocks = 0;
  if (!grid_blocks) {
    int dev = 0, cus = 0, per_cu = 0;
    hipGetDevice(&dev);
    hipDeviceGetAttribute(&cus, hipDeviceAttributeMultiprocessorCount, dev);
    hipOccupancyMaxActiveBlocksPerMultiprocessor(&per_cu, mega_kernel, NTHR, 0);
    if (per_cu < 1) per_cu = 1;
    if (per_cu > 2) per_cu = 2;
    grid_blocks = cus * per_cu;
  }
  Params p{};
  const float* const* in = (const float* const*)d_in;
  p.x = in[0]; p.c = in[1]; p.ada_w = in[2]; p.ada_b = in[3]; p.ln_g = in[4]; p.ln_b = in[5];
  p.ev_w_in = in[6]; p.ev_w_out = in[7]; p.a_lb = in[8]; p.a_ng = in[9]; p.b_mu = in[10]; p.b_w0 = in[11];
  p.b_w1 = in[12]; p.b_w2 = in[13]; p.b_a0 = in[14]; p.b_a1 = in[15]; p.b_a2 = in[16]; p.b_kk = in[17];
  p.b_ka = in[18]; p.b_rk = in[19]; p.b_gng = in[20]; p.b_gnb = in[21]; p.b_vmu = in[22]; p.b_v0 = in[23];
  p.b_v1 = in[24]; p.b_v2 = in[25]; p.od_w_in = in[26]; p.od_cw = in[27]; p.od_cb = in[28]; p.od_wa = in[29];
  p.od_ba = in[30]; p.od_wx = in[31]; p.od_bx = in[32]; p.od_lam = in[33]; p.od_w_out = in[34];
  p.out = (float*)d_out;
  char* ws = (char*)d_ws;
  const size_t MiB = 1024 * 1024;
  p.mod = (float*)(ws);
  p.wev_in = (bf16_t*)(ws + 1 * MiB);
  p.wev_out = (bf16_t*)(ws + 19 * MiB);
  p.wod_in = (bf16_t*)(ws + 23 * MiB);
  p.wod_out = (bf16_t*)(ws + 31 * MiB);
  p.wg = (bf16_t*)(ws + 35 * MiB);
  p.act = (bf16_t*)(ws + 40 * MiB);
  p.vfirst = (bf16_t*)(ws + 104 * MiB);
  p.u = (bf16_t*)(ws + 136 * MiB);
  p.oraw = (float*)(ws + 416 * MiB);
  p.la = (bf16_t*)(ws + 264 * MiB);
  p.uin = (bf16_t*)(ws + 392 * MiB);
  p.bar = (unsigned*)(ws + 900 * 1024);
  p.mixb = (bf16_t*)(ws + 480 * MiB);
  hipMemsetAsync(p.bar, 0, 2 * XCD_BAR_WORDS * sizeof(unsigned), stream);
  void* args[] = {&p};
  hipError_t e = hipLaunchCooperativeKernel((void*)mega_kernel, dim3(grid_blocks), dim3(NTHR), args, 0, stream);
  if (e != hipSuccess) fprintf(stderr, "cooperative launch failed: %s (grid %d)\n", hipGetErrorString(e), grid_blocks);
}
```

```cpp
#include <hip/hip_runtime.h>
#include <hip/hip_bf16.h>
#include <hip/hip_cooperative_groups.h>
#include <cstdio>
namespace cg = cooperative_groups;

typedef unsigned short bf16_t;
using bf16x8 = __attribute__((ext_vector_type(8))) short;
using f32x4 = __attribute__((ext_vector_type(4))) float;

#define NTOK 32768
#define DM 1024
#define SEQ 2048
#define NBATCH 16
#define UE 4480
#define UO 2048
#define C_QA 0
#define C_FA 512
#define C_IA 1024
#define C_GA 1536
#define C_RB 2048
#define C_KB 2560
#define C_VB 3072
#define C_GB 3584
#define C_ZC 4096
#define C_ZP 4256
#define ALPHA 1.681792830507429f
#define SMEM_BYTES 61824
#define NTHR 256
#ifndef NVGPR_CAP
#define NVGPR_CAP 256
#endif
#ifndef REP_H
#define REP_H 1
#endif
#ifndef REP_R
#define REP_R 1
#endif
#ifndef REP_PRE
#define REP_PRE 1
#endif
#ifndef REP_HP
#define REP_HP 1
#endif
#ifndef REP_GIN
#define REP_GIN 1
#endif
#ifndef REP_MIX
#define REP_MIX 1
#endif
#ifndef REP_ODD
#define REP_ODD 1
#endif

#ifdef SKIP_PREP
#define PH_PREP(x)
#else
#define PH_PREP(x) x
#endif
#ifdef SKIP_H0
#define PH_H0(x)
#else
#define PH_H0(x) x
#endif
#ifdef SKIP_GIN
#define PH_GIN(x)
#else
#define PH_GIN(x) x
#endif
#ifdef SKIP_MIX
#define PH_MIX(x)
#else
#define PH_MIX(x) x
#endif
#ifdef SKIP_HPOST
#define PH_HPOST(x)
#else
#define PH_HPOST(x) x
#endif
#ifdef SKIP_CONV
#define PH_CONV(x)
#else
#define PH_CONV(x) x
#endif
#ifdef SKIP_GATES
#define PH_GATES(x)
#else
#define PH_GATES(x) x
#endif
#ifdef SKIP_SCAN
#define PH_SCAN(x)
#else
#define PH_SCAN(x) x
#endif
#ifdef SKIP_GOUT
#define PH_GOUT(x)
#else
#define PH_GOUT(x) x
#endif
#ifdef SKIP_LN
#define PH_LN(x)
#else
#define PH_LN(x) x
#endif

struct Params {
  const float *x, *c, *ada_w, *ada_b, *ln_g, *ln_b, *ev_w_in, *ev_w_out, *a_lb, *a_ng, *b_mu, *b_w0, *b_w1, *b_w2,
      *b_a0, *b_a1, *b_a2, *b_kk, *b_ka, *b_rk, *b_gng, *b_gnb, *b_vmu, *b_v0, *b_v1, *b_v2, *od_w_in, *od_cw, *od_cb,
      *od_wa, *od_ba, *od_wx, *od_bx, *od_lam, *od_w_out;
  float* out;
  float* mod;
  bf16_t *wev_in, *wev_out, *wod_in, *wod_out, *wg, *act, *vfirst, *u;
  float* oraw;
  bf16_t* la;
  bf16_t* uin;
  unsigned* bar;
  bf16_t* mixb;
  int never;
  int pad0;
};

__device__ __forceinline__ int otid() {
  int t = threadIdx.x;
  asm volatile("" : "+v"(t));
  return t;
}
typedef __bf16 hwbf16x2_t __attribute__((ext_vector_type(2)));
typedef float hwf32x2_t __attribute__((ext_vector_type(2)));
__device__ __forceinline__ unsigned short f2bf(float f) {
  __bf16 h = (__bf16)f;
  return __builtin_bit_cast(unsigned short, h);
}
__device__ __forceinline__ float bf2f(unsigned short h) { return __uint_as_float(((unsigned)h) << 16); }
__device__ __forceinline__ unsigned pack2(float a, float b) {
  hwf32x2_t v = {a, b};
  hwbf16x2_t h = __builtin_convertvector(v, hwbf16x2_t);
  return __builtin_bit_cast(unsigned, h);
}
__device__ __forceinline__ float sigm(float x) { return __builtin_amdgcn_rcpf(1.f + __expf(-x)); }
__device__ __forceinline__ float silu(float x) { return x * __builtin_amdgcn_rcpf(1.f + __expf(-x)); }
__device__ __forceinline__ float softplus(float x) { return fmaxf(x, 0.f) + log1pf(__expf(-fabsf(x))); }

__device__ __forceinline__ int gate_perm(int col, int which) {
  return (col >> 6) * 128 + ((col & 63) >> 5) * 64 + ((((col >> 4) & 1) * 2 + which) * 16) + (col & 15);
}

__device__ void transpose_tile(const float* __restrict__ src, int lds_, int r0, int c0, bf16_t* __restrict__ dst,
                               int ldd, int dr0, int dc0, int mode, float* tile) {
  const int tid = otid();
  const int cx = tid & 63, ry = tid >> 6;
#pragma unroll
  for (int i = 0; i < 16; ++i) {
    int row = ry + i * 4;
    tile[row * 65 + cx] = src[(size_t)(r0 + row) * lds_ + c0 + cx];
  }
  __syncthreads();
#pragma unroll
  for (int i = 0; i < 16; ++i) {
    int n = ry + i * 4;
    int drow = (mode == 0) ? (dr0 + n) : gate_perm(c0 + n, mode - 1);
    dst[(size_t)drow * ldd + dc0 + cx] = f2bf(tile[cx * 65 + n]);
  }
  __syncthreads();
}

__device__ void phase_prep(const Params& p, char* smem) {
  float* fs = (float*)smem;
  const int tid = otid();
  const int nT0 = 1792, nT1 = 256, nT2 = 512, nT3 = 1024, nT4 = 512, nT5 = 256, nZ = 2, nM = 192, nC = 320;
  const int total = nT0 + nT1 + nT2 + nT3 + nT4 + nT5 + nZ + nM + nC;
  for (int unit = blockIdx.x; unit < total; unit += gridDim.x) {
    int u = unit;
    if (u < nT0) {
      int e = u / 896, r = u % 896, kt = r / 56, nt = r % 56;
      transpose_tile(p.ev_w_in + (size_t)e * 1024 * 4608, 4608, kt * 64, nt * 64, p.wev_in + (size_t)e * UE * 1024, 1024,
                     nt * 64, kt * 64, 0, fs);
      continue;
    }
    u -= nT0;
    if (u < nT1) {
      int e = u / 128, r = u % 128, kt = r / 8, nt = r % 8;
      transpose_tile(p.ev_w_in + (size_t)e * 1024 * 4608, 4608, kt * 64, 4096 + nt * 64,
                     p.wev_in + (size_t)e * UE * 1024, 1024, 3584 + nt * 64, kt * 64, 0, fs);
      continue;
    }
    u -= nT1;
    if (u < nT2) {
      int e = u / 256, r = u % 256, kt = r / 16, nt = r % 16;
      transpose_tile(p.ev_w_out + (size_t)e * 1024 * 1024, 1024, kt * 64, nt * 64, p.wev_out + (size_t)e * 1024 * 1024,
                     1024, nt * 64, kt * 64, 0, fs);
      continue;
    }
    u -= nT2;
    if (u < nT3) {
      int o = u / 512, r = u % 512, kt = r / 32, nt = r % 32;
      transpose_tile(p.od_w_in + (size_t)o * 1024 * 2048, 2048, kt * 64, nt * 64, p.wod_in + (size_t)o * 2048 * 1024,
                     1024, nt * 64, kt * 64, 0, fs);
      continue;
    }
    u -= nT3;
    if (u < nT4) {
      int o = u / 256, r = u % 256, kt = r / 16, nt = r % 16;
      transpose_tile(p.od_w_out + (size_t)o * 1024 * 1024, 1024, kt * 64, nt * 64, p.wod_out + (size_t)o * 1024 * 1024,
                     1024, nt * 64, kt * 64, 0, fs);
      continue;
    }
    u -= nT4;
    if (u < nT5) {
      int mat = u / 16, r = u % 16, kt = r / 4, nt = r % 4;
      int o = mat / 8, which = (mat / 4) & 1, g = mat & 3;
      const float* src = (which ? p.od_wx : p.od_wa) + (size_t)(o * 4 + g) * 256 * 256;
      transpose_tile(src, 256, kt * 64, nt * 64, p.wg + (size_t)(o * 4 + g) * 512 * 256, 256, 0, kt * 64, 1 + which, fs);
      continue;
    }
    u -= nT5;
    if (u < nZ) {
      uint4 z = make_uint4(0, 0, 0, 0);
      uint4* d = (uint4*)(p.wev_in + (size_t)u * UE * 1024 + (size_t)4416 * 1024);
      for (int i = tid; i < 64 * 1024 * 2 / 16; i += NTHR) d[i] = z;
      continue;
    }
    u -= nZ;
    if (u < nM) {
      int l = u / 48, c0 = (u % 48) * 64;
      int cc = tid & 63, kq = tid >> 6;
      float acc[16];
#pragma unroll
      for (int b = 0; b < 16; ++b) acc[b] = 0.f;
      const float* w = p.ada_w + (size_t)l * 1024 * 3072 + c0 + cc;
      float* sc = fs + kq * 1024;
      for (int ks = 0; ks < 4; ++ks) {
        const int kb = kq * 256 + ks * 64;
#pragma unroll
        for (int b = 0; b < 16; ++b) sc[cc * 16 + b] = silu(p.c[b * 1024 + kb + cc]);
        __syncthreads();
#pragma unroll 4
        for (int kk = 0; kk < 64; ++kk) {
          const float wv = w[(size_t)(kb + kk) * 3072];
          const float4 s0 = *(const float4*)(sc + kk * 16), s1 = *(const float4*)(sc + kk * 16 + 4),
                       s2 = *(const float4*)(sc + kk * 16 + 8), s3 = *(const float4*)(sc + kk * 16 + 12);
          acc[0] += s0.x * wv; acc[1] += s0.y * wv; acc[2] += s0.z * wv; acc[3] += s0.w * wv;
          acc[4] += s1.x * wv; acc[5] += s1.y * wv; acc[6] += s1.z * wv; acc[7] += s1.w * wv;
          acc[8] += s2.x * wv; acc[9] += s2.y * wv; acc[10] += s2.z * wv; acc[11] += s2.w * wv;
          acc[12] += s3.x * wv; acc[13] += s3.y * wv; acc[14] += s3.z * wv; acc[15] += s3.w * wv;
        }
        __syncthreads();
      }
#pragma unroll
      for (int b = 0; b < 16; ++b) fs[(kq * 16 + b) * 64 + cc] = acc[b];
      __syncthreads();
      for (int i = tid; i < 16 * 64; i += NTHR) {
        int b = i >> 6, c2 = i & 63;
        float sm = fs[(0 * 16 + b) * 64 + c2] + fs[(1 * 16 + b) * 64 + c2] + fs[(2 * 16 + b) * 64 + c2] +
                   fs[(3 * 16 + b) * 64 + c2];
        p.mod[((size_t)l * 16 + b) * 3072 + c0 + c2] = sm + p.ada_b[l * 3072 + c0 + c2];
      }
      __syncthreads();
      continue;
    }
    u -= nM;
    {
      int e = u / 160, r = u % 160, cp = r / 80, r2 = r % 80, dt = r2 / 5, jt = r2 % 5;
      int d0 = dt * 64, j0 = jt * 32;
      float* sA = fs;
      float* sB = fs + 64 * 33;
      const float* M = nullptr;
      const float* mu = nullptr;
      int ldm = 64, jm = 0;
      if (jt < 2) { M = p.b_w1 + (size_t)e * 512 * 64; mu = p.b_mu + (size_t)e * 5 * 512 + 3 * 512; ldm = 64; jm = j0; }
      else if (jt < 4) { M = p.b_a1 + (size_t)e * 512 * 64; mu = p.b_mu + (size_t)e * 5 * 512 + 4 * 512; ldm = 64; jm = j0 - 64; }
      else if (e >= 1) { M = p.b_v1 + (size_t)(e - 1) * 512 * 32; mu = p.b_vmu + (size_t)(e - 1) * 512; ldm = 32; jm = 0; }
      float acc[8];
#pragma unroll
      for (int i = 0; i < 8; ++i) acc[i] = 0.f;
      const int jj = tid & 31, dg = tid >> 5;
      if (M != nullptr) {
        const float* win = p.ev_w_in + (size_t)e * 1024 * 4608 + 3584;
        for (int z0 = 0; z0 < 512; z0 += 32) {
          for (int i = tid; i < 64 * 32; i += NTHR) {
            int dd = i >> 5, zz = i & 31;
            sA[dd * 33 + zz] = win[(size_t)(d0 + dd) * 4608 + z0 + zz];
          }
          for (int i = tid; i < 32 * 32; i += NTHR) {
            int zz = i >> 5, j2 = i & 31;
            float m = mu[z0 + zz];
            float s = cp ? m : (1.f - m);
            sB[zz * 33 + j2] = s * M[(size_t)(z0 + zz) * ldm + jm + j2];
          }
          __syncthreads();
#pragma unroll 8
          for (int zz = 0; zz < 32; ++zz) {
            float bv = sB[zz * 33 + jj];
#pragma unroll
            for (int i = 0; i < 8; ++i) acc[i] += sA[(dg * 8 + i) * 33 + zz] * bv;
          }
          __syncthreads();
        }
      }
      bf16_t* dst = p.wev_in + (size_t)e * UE * 1024 + (size_t)(4096 + cp * 160 + j0 + jj) * 1024 + d0 + dg * 8;
#pragma unroll
      for (int i = 0; i < 8; ++i) dst[i] = f2bf(acc[i]);
    }
  }
}

__device__ void phase_h0(const Params& p) {
  const size_t n8 = (size_t)NTOK * DM / 8;
  for (size_t i = (size_t)blockIdx.x * NTHR + otid(); i < n8; i += (size_t)gridDim.x * NTHR) {
    size_t e0 = i * 8;
    int tok = (int)(e0 >> 10), col = (int)(e0 & 1023);
    int b = tok >> 11;
    const float* md = p.mod + (size_t)b * 3072;
    float4 x0 = *(const float4*)(p.x + e0), x1 = *(const float4*)(p.x + e0 + 4);
    float4 sh0 = *(const float4*)(md + col), sh1 = *(const float4*)(md + col + 4);
    float4 sc0 = *(const float4*)(md + 1024 + col), sc1 = *(const float4*)(md + 1024 + col + 4);
    uint4 o;
    o.x = pack2(x0.x * (1.f + sc0.x) + sh0.x, x0.y * (1.f + sc0.y) + sh0.y);
    o.y = pack2(x0.z * (1.f + sc0.z) + sh0.z, x0.w * (1.f + sc0.w) + sh0.w);
    o.z = pack2(x1.x * (1.f + sc1.x) + sh1.x, x1.y * (1.f + sc1.y) + sh1.y);
    o.w = pack2(x1.z * (1.f + sc1.z) + sh1.z, x1.w * (1.f + sc1.w) + sh1.w);
    *(uint4*)(p.act + e0) = o;
  }
}

#define GEMM_SLOTS_DECL uint4 rA0_0, rA1_0, rA2_0, rA3_0, rB0_0, rB1_0, rB2_0, rB3_0, rA0_1, rA1_1, rA2_1, rA3_1, rB0_1, rB1_1, rB2_1, rB3_1;
#define GEMM_SLOTS_ARGS rA0_0, rA1_0, rA2_0, rA3_0, rB0_0, rB1_0, rB2_0, rB3_0, rA0_1, rA1_1, rA2_1, rA3_1, rB0_1, rB1_1, rB2_1, rB3_1
__device__ __forceinline__ void gemm_mainloop(const bf16_t* __restrict__ A, int lda, const bf16_t* __restrict__ Bt,
                                              int ldb, int K, f32x4 (&acc)[4][4], char* smem,
                                              const bf16_t* __restrict__ A2, int lda2, int ksplit,
                                              uint4& rA0_0, uint4& rA1_0, uint4& rA2_0, uint4& rA3_0, uint4& rB0_0, uint4& rB1_0, uint4& rB2_0, uint4& rB3_0, uint4& rA0_1, uint4& rA1_1, uint4& rA2_1, uint4& rA3_1, uint4& rB0_1, uint4& rB1_1, uint4& rB2_1, uint4& rB3_1,
                                              bool preloaded, const bf16_t* __restrict__ nextA, const bf16_t* __restrict__ nextBt) {
  bf16_t* sA = (bf16_t*)smem;
  bf16_t* sB = sA + 128 * 64;
  const int tid = otid(), lane = tid & 63, wid = tid >> 6, wr = wid >> 1, wc = wid & 1, fr = lane & 15,
            fq = lane >> 4;
  const int lrow = tid >> 3, lc = tid & 7;
  const int wofs = lrow * 64 + ((lc ^ ((lrow >> 1) & 7)) * 8);
  const int rs0 = ((fq) ^ ((fr >> 1) & 7)) * 8, rs1 = ((4 + fq) ^ ((fr >> 1) & 7)) * 8;
  const bf16_t* ga = A + (size_t)lrow * lda + lc * 8;
  const bf16_t* ga2 = A2 + (size_t)lrow * lda2 + lc * 8;
  const size_t a32b = (size_t)32 * lda2;
  const bf16_t* gb = Bt + (size_t)lrow * ldb + lc * 8;
  const size_t a32 = (size_t)32 * lda, b32 = (size_t)32 * ldb;
#pragma unroll
  for (int i = 0; i < 4; ++i)
#pragma unroll
    for (int j = 0; j < 4; ++j) acc[i][j] = (f32x4){0.f, 0.f, 0.f, 0.f};
  const int nk = K >> 6;
#define LD_SLOT(s, kt_)                                                                   \
  {                                                                                       \
    const bf16_t* pa_ = ((kt_) < ksplit) ? (ga + (kt_)*64) : (ga2 + ((kt_)-ksplit) * 64);  \
    const size_t st_ = ((kt_) < ksplit) ? a32 : a32b;                                      \
    rA0_##s = *(const uint4*)(pa_);                                                       \
    rA1_##s = *(const uint4*)(pa_ + st_);                                                 \
    rA2_##s = *(const uint4*)(pa_ + 2 * st_);                                             \
    rA3_##s = *(const uint4*)(pa_ + 3 * st_);                                             \
  }                                                                                       \
  rB0_##s = *(const uint4*)(gb + (kt_)*64);                 \
  rB1_##s = *(const uint4*)(gb + b32 + (kt_)*64);           \
  rB2_##s = *(const uint4*)(gb + 2 * b32 + (kt_)*64);       \
  rB3_##s = *(const uint4*)(gb + 3 * b32 + (kt_)*64);
#define ST_SLOT(s)                                \
  *(uint4*)(sA + wofs) = rA0_##s;                 \
  *(uint4*)(sA + wofs + 32 * 64) = rA1_##s;       \
  *(uint4*)(sA + wofs + 64 * 64) = rA2_##s;       \
  *(uint4*)(sA + wofs + 96 * 64) = rA3_##s;       \
  *(uint4*)(sB + wofs) = rB0_##s;                 \
  *(uint4*)(sB + wofs + 32 * 64) = rB1_##s;       \
  *(uint4*)(sB + wofs + 64 * 64) = rB2_##s;       \
  *(uint4*)(sB + wofs + 96 * 64) = rB3_##s;
  if (!preloaded) {
    LD_SLOT(0, 0)
    LD_SLOT(1, 1)
  }
  ST_SLOT(0)
  LD_SLOT(0, 2)
  __syncthreads();
#define GEMM_STEP(sl)                                                                                             \
  {                                                                                                               \
    const bf16_t* pa = sA + (wr * 64 + fr) * 64;                                                                  \
    const bf16_t* pb = sB + (wc * 64 + fr) * 64;                                                                  \
    bf16x8 af[4], bfr[4];                                                                                         \
    _Pragma("unroll") for (int t = 0; t < 4; ++t) {                                                               \
      af[t] = *(const bf16x8*)(pa + t * 16 * 64 + rs0);                                                           \
      bfr[t] = *(const bf16x8*)(pb + t * 16 * 64 + rs0);                                                          \
    }                                                                                                             \
    __builtin_amdgcn_s_setprio(1);                                                                                \
    _Pragma("unroll") for (int mt = 0; mt < 4; ++mt) _Pragma("unroll") for (int nt = 0; nt < 4; ++nt)             \
        acc[mt][nt] = __builtin_amdgcn_mfma_f32_16x16x32_bf16(bfr[nt], af[mt], acc[mt][nt], 0, 0, 0);             \
    __builtin_amdgcn_s_setprio(0);                                                                                \
    _Pragma("unroll") for (int t = 0; t < 4; ++t) {                                                               \
      af[t] = *(const bf16x8*)(pa + t * 16 * 64 + rs1);                                                           \
      bfr[t] = *(const bf16x8*)(pb + t * 16 * 64 + rs1);                                                          \
    }                                                                                                             \
    __builtin_amdgcn_s_setprio(1);                                                                                \
    _Pragma("unroll") for (int mt = 0; mt < 4; ++mt) _Pragma("unroll") for (int nt = 0; nt < 4; ++nt)             \
        acc[mt][nt] = __builtin_amdgcn_mfma_f32_16x16x32_bf16(bfr[nt], af[mt], acc[mt][nt], 0, 0, 0);             \
    __builtin_amdgcn_s_setprio(0);                                                                                \
    __syncthreads();                                                                                              \
    if (kt + 1 < nk) { ST_SLOT(sl) }                                                                              \
    if (kt + 3 < nk) { LD_SLOT(sl, kt + 3) }                                                                      \
    __syncthreads();                                                                                              \
  }
  for (int kt0 = 0; kt0 < nk; kt0 += 2) {
    { const int kt = kt0; GEMM_STEP(1) }
    { const int kt = kt0 + 1; GEMM_STEP(0) }
  }
  if (nextA != nullptr) {
    const bf16_t* gan = nextA + (size_t)lrow * lda + lc * 8;
    const bf16_t* gbn = nextBt + (size_t)lrow * ldb + lc * 8;
    rA0_0 = *(const uint4*)(gan);            rA1_0 = *(const uint4*)(gan + a32);
    rA2_0 = *(const uint4*)(gan + 2 * a32);  rA3_0 = *(const uint4*)(gan + 3 * a32);
    rB0_0 = *(const uint4*)(gbn);            rB1_0 = *(const uint4*)(gbn + b32);
    rB2_0 = *(const uint4*)(gbn + 2 * b32);  rB3_0 = *(const uint4*)(gbn + 3 * b32);
    rA0_1 = *(const uint4*)(gan + 64);            rA1_1 = *(const uint4*)(gan + a32 + 64);
    rA2_1 = *(const uint4*)(gan + 2 * a32 + 64);  rA3_1 = *(const uint4*)(gan + 3 * a32 + 64);
    rB0_1 = *(const uint4*)(gbn + 64);            rB1_1 = *(const uint4*)(gbn + b32 + 64);
    rB2_1 = *(const uint4*)(gbn + 2 * b32 + 64);  rB3_1 = *(const uint4*)(gbn + 3 * b32 + 64);
  }
#undef GEMM_STEP
#undef LD_SLOT
#undef ST_SLOT
}


__device__ __forceinline__ void store_tile_bf16(f32x4 (&acc)[4][4], bf16_t* __restrict__ C, int ldc, int m0, int n0,
                                                char* smem) {
  bf16_t* sC = (bf16_t*)smem;
  const int tid = otid(), lane = tid & 63, wid = tid >> 6, wr = wid >> 1, wc = wid & 1, fr = lane & 15, fq = lane >> 4;
#pragma unroll
  for (int mt = 0; mt < 4; ++mt) {
    const int m = wr * 64 + mt * 16 + fr;
#pragma unroll
    for (int nt = 0; nt < 4; ++nt) {
      const int n = wc * 64 + nt * 16 + fq * 4;
      uint2 v;
      v.x = pack2(acc[mt][nt][0], acc[mt][nt][1]);
      v.y = pack2(acc[mt][nt][2], acc[mt][nt][3]);
      *(uint2*)(sC + m * 136 + n) = v;
    }
  }
  __syncthreads();
  const int row = tid >> 4, c16 = tid & 15;
#pragma unroll
  for (int ps = 0; ps < 8; ++ps) {
    const int r = ps * 16 + row;
    const uint4 v = *(const uint4*)(sC + r * 136 + c16 * 8);
    *(uint4*)(C + (size_t)(m0 + r) * ldc + n0 + c16 * 8) = v;
  }
  __syncthreads();
}

__device__ void phase_gemm_in_range(const Params& p, const bf16_t* Wt, int ldc, int nt0, int ntn, int b0, int nb,
                                    char* smem) {
  const int ntiles = (NTOK / 128) * ntn;
  const int lane = otid() & 63, wid = otid() >> 6, wr = wid >> 1, wc = wid & 1, fr = lane & 15, fq = lane >> 4;
  const int bloc = (int)blockIdx.x - b0, tpx = ntiles >> 3, nbx = nb >> 3;
  GEMM_SLOTS_DECL
  bool preloaded = false;
  for (int lt = bloc >> 3; lt < tpx; lt += nbx) {
    const int t = (bloc & 7) * tpx + lt;
    const int m0 = (t / ntn) * 128, n0 = (nt0 + (t % ntn)) * 128;
    const bool more = (lt + nbx < tpx);
    const int t2 = (bloc & 7) * tpx + lt + nbx;
    const bf16_t* nA = more ? (p.act + (size_t)((t2 / ntn) * 128) * DM) : nullptr;
    const bf16_t* nB = more ? (Wt + (size_t)((nt0 + (t2 % ntn)) * 128) * DM) : nullptr;
    f32x4 acc[4][4];
    gemm_mainloop(p.act + (size_t)m0 * DM, DM, Wt + (size_t)n0 * DM, DM, DM, acc, smem, p.act, DM, 1 << 20, GEMM_SLOTS_ARGS, preloaded, nA, nB);
    preloaded = more;
    store_tile_bf16(acc, p.u, ldc, m0, n0, smem);
  }
}

__device__ void phase_gemm_in(const Params& p, const bf16_t* Wt, int N, int ldc, char* smem) {
  const int ntn = N / 128, ntiles = (NTOK / 128) * ntn;
  const int lane = otid() & 63, wid = otid() >> 6, wr = wid >> 1, wc = wid & 1, fr = lane & 15, fq = lane >> 4;
  const int tpx = ntiles >> 3, nbx = gridDim.x >> 3, xcd = blockIdx.x & 7;
  for (int lt = (gridDim.x == 512) ? ((((blockIdx.x >> 3) & 31) << 1) + (blockIdx.x >> 8)) : (blockIdx.x >> 3); lt < tpx; lt += nbx) {
    const int t = xcd * tpx + lt;
    const int m0 = (t / ntn) * 128, n0 = (t % ntn) * 128;
    f32x4 acc[4][4];
    GEMM_SLOTS_DECL
    gemm_mainloop(p.act + (size_t)m0 * DM, DM, Wt + (size_t)n0 * DM, DM, DM, acc, smem, p.act, DM, 1 << 20, GEMM_SLOTS_ARGS, false, nullptr, nullptr);
    store_tile_bf16(acc, p.u, ldc, m0, n0, smem);
  }
}

__device__ void phase_gemm_out(const Params& p, int l, const bf16_t* Wt, char* smem, bool splitA) {
  const int ntn = DM / 128, ntiles = (NTOK / 128) * ntn;
  const int lane = otid() & 63, wid = otid() >> 6, wr = wid >> 1, wc = wid & 1, fr = lane & 15, fq = lane >> 4;
  const float* xin = (l == 0) ? p.x : p.out;
  const int tpx = ntiles >> 3, nbx = gridDim.x >> 3, xcd = blockIdx.x & 7;
  for (int lt = (gridDim.x == 512) ? ((((blockIdx.x >> 3) & 31) << 1) + (blockIdx.x >> 8)) : (blockIdx.x >> 3); lt < tpx; lt += nbx) {
    const int t = xcd * tpx + lt;
    const int m0 = (t / ntn) * 128, n0 = (t % ntn) * 128;
    f32x4 acc[4][4];
    GEMM_SLOTS_DECL
    gemm_mainloop(p.act + (size_t)m0 * DM, DM, Wt + (size_t)n0 * DM, DM, DM, acc, smem,
                  splitA ? (p.mixb + (size_t)m0 * 512) : p.act, splitA ? 512 : DM, splitA ? 8 : (1 << 20), GEMM_SLOTS_ARGS, false, nullptr, nullptr);
    const int b = m0 >> 11;
    const float* gate = p.mod + ((size_t)l * 16 + b) * 3072 + 2048;
#pragma unroll
    for (int mt = 0; mt < 4; ++mt) {
      const int m = m0 + wr * 64 + mt * 16 + fr;
#pragma unroll
      for (int nt = 0; nt < 4; ++nt) {
        const int n = n0 + wc * 64 + nt * 16 + fq * 4;
        float4 xv = *(const float4*)(xin + (size_t)m * DM + n);
        float4 gv = *(const float4*)(gate + n);
        float4 o;
        o.x = ALPHA * xv.x + (1.f + gv.x) * acc[mt][nt][0];
        o.y = ALPHA * xv.y + (1.f + gv.y) * acc[mt][nt][1];
        o.z = ALPHA * xv.z + (1.f + gv.z) * acc[mt][nt][2];
        o.w = ALPHA * xv.w + (1.f + gv.w) * acc[mt][nt][3];
        *(float4*)(p.out + (size_t)m * DM + n) = o;
      }
    }
  }
}

__device__ void phase_ln(const Params& p, int l) {
  const int lane = otid() & 63, wid = otid() >> 6;
  const int nw = gridDim.x * 4;
  const float* g = p.ln_g + l * 1024;
  const float* bb = p.ln_b + l * 1024;
  for (int row0 = (blockIdx.x * 4 + wid) * 4; row0 < NTOK; row0 += nw * 4) {
    float4 v[4][4];
#pragma unroll
    for (int rr = 0; rr < 4; ++rr)
#pragma unroll
      for (int i = 0; i < 4; ++i) v[rr][i] = *(const float4*)(p.out + (size_t)(row0 + rr) * DM + i * 256 + lane * 4);
    float mu[4], rstd[4];
#pragma unroll
    for (int rr = 0; rr < 4; ++rr) {
      float s = 0.f;
#pragma unroll
      for (int i = 0; i < 4; ++i) s += v[rr][i].x + v[rr][i].y + v[rr][i].z + v[rr][i].w;
#pragma unroll
      for (int m = 32; m >= 1; m >>= 1) s += __shfl_xor(s, m);
      mu[rr] = s * (1.f / 1024.f);
      float q = 0.f;
#pragma unroll
      for (int i = 0; i < 4; ++i) {
        float a = v[rr][i].x - mu[rr], b2 = v[rr][i].y - mu[rr], c2 = v[rr][i].z - mu[rr], d2 = v[rr][i].w - mu[rr];
        q += a * a + b2 * b2 + c2 * c2 + d2 * d2;
      }
#pragma unroll
      for (int m = 32; m >= 1; m >>= 1) q += __shfl_xor(q, m);
      rstd[rr] = rsqrtf(q * (1.f / 1024.f) + 1e-5f);
    }
    const int b = row0 >> 11;
    const float* md = p.mod + ((size_t)(l + 1) * 16 + b) * 3072;
#pragma unroll
    for (int i = 0; i < 4; ++i) {
      const int col = i * 256 + lane * 4;
      const float4 gg = *(const float4*)(g + col), bv = *(const float4*)(bb + col);
      float4 sh = make_float4(0.f, 0.f, 0.f, 0.f), sc = sh;
      if (l < 3) { sh = *(const float4*)(md + col); sc = *(const float4*)(md + 1024 + col); }
#pragma unroll
      for (int rr = 0; rr < 4; ++rr) {
        float4 o;
        o.x = (v[rr][i].x - mu[rr]) * rstd[rr] * gg.x + bv.x;
        o.y = (v[rr][i].y - mu[rr]) * rstd[rr] * gg.y + bv.y;
        o.z = (v[rr][i].z - mu[rr]) * rstd[rr] * gg.z + bv.z;
        o.w = (v[rr][i].w - mu[rr]) * rstd[rr] * gg.w + bv.w;
        {
          f32x4 ov4 = {o.x, o.y, o.z, o.w};
          __builtin_nontemporal_store(ov4, (f32x4*)(p.out + (size_t)(row0 + rr) * DM + col));
        }
        if (l < 3) {
          uint2 h;
          h.x = pack2(o.x * (1.f + sc.x) + sh.x, o.y * (1.f + sc.y) + sh.y);
          h.y = pack2(o.z * (1.f + sc.z) + sh.z, o.w * (1.f + sc.w) + sh.w);
          *(uint2*)(p.act + (size_t)(row0 + rr) * DM + col) = h;
        }
      }
    }
  }
}

template <int CTRL>
__device__ __forceinline__ float dppf(float x) {
  return __int_as_float(__builtin_amdgcn_update_dpp(0, __float_as_int(x), CTRL, 0xf, 0xf, true));
}
__device__ __forceinline__ float red8(float x) {
  x += dppf<0xB1>(x);
  x += dppf<0x4E>(x);
  x += dppf<0x141>(x);
  return x;
}
__device__ __forceinline__ float red16(float x) {
  x = red8(x);
  x += dppf<0x140>(x);
  return x;
}
__device__ __forceinline__ float red64(float x) {
  x = red16(x);
  float a = __int_as_float(__builtin_amdgcn_readlane(__float_as_int(x), 0));
  float b = __int_as_float(__builtin_amdgcn_readlane(__float_as_int(x), 16));
  float c = __int_as_float(__builtin_amdgcn_readlane(__float_as_int(x), 32));
  float d = __int_as_float(__builtin_amdgcn_readlane(__float_as_int(x), 48));
  return (a + b) + (c + d);
}
__device__ __forceinline__ float bflo(unsigned w) { return __uint_as_float(w << 16); }
__device__ __forceinline__ float bfhi(unsigned w) { return __uint_as_float(w & 0xffff0000u); }

__device__ void hgrn2_item(const Params& p, int e, int item, char* smem) {
  const int tid = otid();
  const int b = item >> 4, h = (item >> 2) & 3, vq = item & 3;
  float* qs = (float*)smem;
  float* fsm = qs + 32 * 128;
  float* is = fsm + 32 * 128;
  float* ob = is + 32 * 32;
  const int lt = tid >> 3, lq = tid & 7;
  float lbv[16];
#pragma unroll
  for (int j = 0; j < 16; ++j) {
    int ch = h * 128 + lq * 16 + j;
    if (e == 0) lbv[j] = 0.f;
    else {
      float l0 = p.a_lb[ch], l1 = p.a_lb[512 + ch];
      lbv[j] = 1.f / (1.f + __expf(l0 - l1));
    }
  }
  const int vp = tid >> 4, ksl = tid & 15, k0 = ksl * 8;
  const int rl = tid & 63, vpl = (tid >> 4) & 3, wid4 = (tid >> 6) * 4;
  float* pb = ob + 32 * 32 + (tid >> 6) * 1024;
  typedef float f32x2v __attribute__((ext_vector_type(2)));
  f32x2v S01[8];
#pragma unroll
  for (int j = 0; j < 8; ++j) S01[j] = (f32x2v){0.f, 0.f};
  const size_t tokbase = (size_t)b * SEQ;
  uint4 q0, q1, z0, z1;
  uint2 iv;
  {
    const bf16_t* row = p.u + (tokbase + lt) * UE;
    q0 = *(const uint4*)(row + C_QA + h * 128 + lq * 16);
    q1 = *(const uint4*)(row + C_QA + h * 128 + lq * 16 + 8);
    z0 = *(const uint4*)(row + C_FA + h * 128 + lq * 16);
    z1 = *(const uint4*)(row + C_FA + h * 128 + lq * 16 + 8);
    iv = *(const uint2*)(row + C_IA + h * 128 + vq * 32 + lq * 4);
  }
  for (int c0 = 0; c0 < SEQ; c0 += 32) {
    {
      unsigned qa[8] = {q0.x, q0.y, q0.z, q0.w, q1.x, q1.y, q1.z, q1.w};
      unsigned za[8] = {z0.x, z0.y, z0.z, z0.w, z1.x, z1.y, z1.z, z1.w};
#pragma unroll
      for (int j2 = 0; j2 < 8; ++j2) {
        float qa0 = bflo(qa[j2]), qa1 = bfhi(qa[j2]);
        float za0 = bflo(za[j2]), za1 = bfhi(za[j2]);
        float f0 = lbv[2 * j2] + (1.f - lbv[2 * j2]) * sigm(za0);
        float f1 = lbv[2 * j2 + 1] + (1.f - lbv[2 * j2 + 1]) * sigm(za1);
        *(float2*)(qs + lt * 128 + lq * 16 + 2 * j2) = make_float2(qa0, qa1);
        *(float2*)(fsm + lt * 128 + lq * 16 + 2 * j2) = make_float2(f0, f1);
      }
      *(float4*)(is + lt * 32 + lq * 4) = make_float4(bflo(iv.x), bfhi(iv.x), bflo(iv.y), bfhi(iv.y));
    }
    __syncthreads();
    if (c0 + 32 < SEQ) {
      const bf16_t* row = p.u + (tokbase + c0 + 32 + lt) * UE;
      q0 = *(const uint4*)(row + C_QA + h * 128 + lq * 16);
      q1 = *(const uint4*)(row + C_QA + h * 128 + lq * 16 + 8);
      z0 = *(const uint4*)(row + C_FA + h * 128 + lq * 16);
      z1 = *(const uint4*)(row + C_FA + h * 128 + lq * 16 + 8);
      iv = *(const uint2*)(row + C_IA + h * 128 + vq * 32 + lq * 4);
    }
    float2 i2n = *(const float2*)(is + 2 * vp);
    float4 fan = *(const float4*)(fsm + k0), fbn = *(const float4*)(fsm + k0 + 4);
    float4 qan = *(const float4*)(qs + k0), qbn = *(const float4*)(qs + k0 + 4);
    for (int t0 = 0; t0 < 32; t0 += 8) {
#pragma unroll 4
      for (int tt = 0; tt < 8; ++tt) {
        const int t = t0 + tt;
        const float2 i2 = i2n;
        const float4 fa = fan, fb = fbn, qa = qan, qb = qbn;
        {
          const int tn = (t + 1 < 32) ? (t + 1) : 31;
          i2n = *(const float2*)(is + tn * 32 + 2 * vp);
          fan = *(const float4*)(fsm + tn * 128 + k0); fbn = *(const float4*)(fsm + tn * 128 + k0 + 4);
          qan = *(const float4*)(qs + tn * 128 + k0); qbn = *(const float4*)(qs + tn * 128 + k0 + 4);
        }
        const float f[8] = {fa.x, fa.y, fa.z, fa.w, fb.x, fb.y, fb.z, fb.w};
        const float q[8] = {qa.x, qa.y, qa.z, qa.w, qb.x, qb.y, qb.z, qb.w};
        const f32x2v iv = (f32x2v){i2.x, i2.y};
        f32x2v o01 = (f32x2v){0.f, 0.f};
#pragma unroll
        for (int j = 0; j < 8; ++j) {
          S01[j] = f[j] * (S01[j] - iv) + iv;
          o01 = q[j] * S01[j] + o01;
        }
        const float o0 = o01.x, o1 = o01.y;
        pb[((tt * 4 + vpl) * 2 + 0) * 16 + ksl] = o0;
        pb[((tt * 4 + vpl) * 2 + 1) * 16 + ksl] = o1;
      }
      {
        const float4* rp = (const float4*)(pb + rl * 16);
        const float4 r0 = rp[0], r1 = rp[1], r2 = rp[2], r3 = rp[3];
        const float sum = ((r0.x + r0.y) + (r0.z + r0.w)) + ((r1.x + r1.y) + (r1.z + r1.w)) +
                          (((r2.x + r2.y) + (r2.z + r2.w)) + ((r3.x + r3.y) + (r3.z + r3.w)));
        ob[(t0 + (rl >> 3)) * 32 + 2 * (wid4 + ((rl >> 1) & 3)) + (rl & 1)] = sum;
      }
    }
    __syncthreads();
    {
      float4 ov = *(const float4*)(ob + lt * 32 + lq * 4);
      *(float4*)(p.oraw + (tokbase + c0 + lt) * 512 + h * 128 + vq * 32 + lq * 4) = ov;
    }
  }
  __syncthreads();
}

using f16x8 = __attribute__((ext_vector_type(8))) _Float16;
__device__ __forceinline__ unsigned short f2h(float f) {
  _Float16 hv = (_Float16)f;
  return __builtin_bit_cast(unsigned short, hv);
}
__device__ __forceinline__ float fast_tanh(float x) { return 1.f - 2.f * __builtin_amdgcn_rcpf(1.f + __expf(2.f * x)); }
__device__ __forceinline__ float fast_softplus(float x) { return fmaxf(x, 0.f) + __logf(1.f + __expf(-fabsf(x))); }

__device__ void rwkv_item(const Params& p, int e, int item, char* smem) {
  const int tid = otid(), lane = tid & 63, wid = tid >> 6;
  const int fr = lane & 15, fq = lane >> 4;
  const int b = item >> 3, h = item & 7;
  float* rsA = (float*)smem;
  float* kraw = (float*)(smem + 4096);
  float* yb = kraw;
  float* vs = (float*)(smem + 8192);
  float* pre_w = (float*)(smem + 12288);
  float* pre_a = (float*)(smem + 16384);
  float* pre_v = (float*)(smem + 20480);
  bf16_t* At = (bf16_t*)(smem + 12288);
  bf16_t* Rt = At + 16 * 72;
  bf16_t* Bt = Rt + 16 * 72;
  bf16_t* Kt = Bt + 16 * 72;
  bf16_t* BKT = (bf16_t*)(smem + 12288 + 9216);
  bf16_t* VmT = BKT + 64 * 40;
  float* gL = (float*)(smem + 12288 + 9216 + 5120 + 3072);
  float* ldsum = (float*)(smem + 29952);
  float* cbs = (float*)(smem + 30976);
  bf16_t* S0b = (bf16_t*)(smem + 31040);
  char* wp = smem + 40256 + wid * 4864;
  float* Nt = (float*)wp;
  bf16_t* MT2 = (bf16_t*)(wp + 1024);
  bf16_t* MakT = (bf16_t*)(wp + 2304);
  float* Pbuf = (float*)(wp + 3584);
  bf16_t* L1b = (bf16_t*)(smem + 40256);
  const size_t tokbase = (size_t)b * SEQ;
  const float* mu = p.b_mu + (size_t)e * 5 * 512;
  bf16x8 w2f[2], a2f[2], v2f;
  {
    const int lcg = h * 64 + wid * 16 + fr;
#pragma unroll
    for (int ks = 0; ks < 2; ++ks)
#pragma unroll
      for (int i = 0; i < 8; ++i) {
        w2f[ks][i] = (short)f2bf(p.b_w2[(size_t)e * 64 * 512 + (size_t)(ks * 32 + fq * 8 + i) * 512 + lcg]);
        a2f[ks][i] = (short)f2bf(p.b_a2[(size_t)e * 64 * 512 + (size_t)(ks * 32 + fq * 8 + i) * 512 + lcg]);
      }
#pragma unroll
    for (int i = 0; i < 8; ++i)
      v2f[i] = (e >= 1) ? (short)f2bf(p.b_v2[(size_t)(e - 1) * 32 * 512 + (size_t)(fq * 8 + i) * 512 + lcg]) : (short)0;
  }
  const int bch = tid & 63, btg = tid >> 6, bcg = h * 64 + bch;
  const float w0 = p.b_w0[e * 512 + bcg], a0 = p.b_a0[e * 512 + bcg], kkc = p.b_kk[e * 512 + bcg],
              kac = p.b_ka[e * 512 + bcg], rkc = p.b_rk[e * 512 + bcg];
  const float v0c = (e >= 1) ? p.b_v0[(e - 1) * 512 + bcg] : 0.f;
  const int at = tid >> 4, aq = tid & 15;
  float* cst = (float*)(smem + 59712);
  float* gLm = (float*)(smem + 60992);
  float* gm = (float*)(smem + 61248);
  float* kkcs = (float*)(smem + 61504);
  float* kss = (float*)(smem + 61760);
  if (tid < 64) {
    const int cgj = h * 64 + tid;
    cst[tid] = mu[0 * 512 + cgj];
    cst[64 + tid] = mu[1 * 512 + cgj];
    cst[128 + tid] = mu[2 * 512 + cgj];
    cst[192 + tid] = p.b_gng[e * 512 + cgj];
    cst[256 + tid] = p.b_gnb[e * 512 + cgj];
    kkcs[tid] = p.b_kk[e * 512 + cgj];
  }
  f32x4 Sacc[4];
#pragma unroll
  for (int nt = 0; nt < 4; ++nt) Sacc[nt] = (f32x4){0.f, 0.f, 0.f, 0.f};

  uint2 rc, kc, vc, rp, kp, vpv, gnx;
  unsigned zc[5], zp[5];
  unsigned short vfn[4] = {0, 0, 0, 0};
  auto load_chunk = [&](int c0) {
    const int tg = c0 + at;
    const bf16_t* row = p.u + (tokbase + tg) * UE;
    const bf16_t* prow = row - UE;
    const bool hp = (tg > 0);
    rc = *(const uint2*)(row + C_RB + h * 64 + aq * 4);
    kc = *(const uint2*)(row + C_KB + h * 64 + aq * 4);
    vc = *(const uint2*)(row + C_VB + h * 64 + aq * 4);
    gnx = *(const uint2*)(row + C_GB + h * 64 + aq * 4);
    rp = make_uint2(0, 0); kp = make_uint2(0, 0); vpv = make_uint2(0, 0);
    if (hp) {
      rp = *(const uint2*)(prow + C_RB + h * 64 + aq * 4);
      kp = *(const uint2*)(prow + C_KB + h * 64 + aq * 4);
      vpv = *(const uint2*)(prow + C_VB + h * 64 + aq * 4);
    }
#pragma unroll
    for (int i = 0; i < 5; ++i) {
      zc[i] = *(const unsigned*)(row + C_ZC + aq * 10 + 2 * i);
      zp[i] = hp ? *(const unsigned*)(prow + C_ZP + aq * 10 + 2 * i) : 0u;
    }
    if (e >= 1) {
#pragma unroll
      for (int i = 0; i < 4; ++i) vfn[i] = p.vfirst[(tokbase + c0 + btg * 4 + i) * 512 + bcg];
    }
  };
  load_chunk(0);
  __syncthreads();

  for (int c0 = 0; c0 < SEQ; c0 += 16) {
    uint2 gcur = gnx;
    unsigned short vfc[4] = {vfn[0], vfn[1], vfn[2], vfn[3]};
    {
      int tA = tid; asm volatile("" : "+v"(tA));
      const int at = tA >> 4, aq = tA & 15;
      unsigned rca[2] = {rc.x, rc.y}, kca[2] = {kc.x, kc.y}, vca[2] = {vc.x, vc.y};
      unsigned rpa[2] = {rp.x, rp.y}, kpa[2] = {kp.x, kp.y}, vpa[2] = {vpv.x, vpv.y};
      float ro[4], ko[4], vo[4];
      const float4 mr4 = *(const float4*)(cst + aq * 4), mk4 = *(const float4*)(cst + 64 + aq * 4),
                   mv4 = *(const float4*)(cst + 128 + aq * 4);
      const float mur[4] = {mr4.x, mr4.y, mr4.z, mr4.w}, muk[4] = {mk4.x, mk4.y, mk4.z, mk4.w},
                  muv[4] = {mv4.x, mv4.y, mv4.z, mv4.w};
#pragma unroll
      for (int j2 = 0; j2 < 2; ++j2) {
        float r0 = bflo(rca[j2]), r1 = bflo(rpa[j2]), r2 = bfhi(rca[j2]), r3 = bfhi(rpa[j2]);
        float k0f = bflo(kca[j2]), k1f = bflo(kpa[j2]), k2f = bfhi(kca[j2]), k3f = bfhi(kpa[j2]);
        float v0f = bflo(vca[j2]), v1f = bflo(vpa[j2]), v2f2 = bfhi(vca[j2]), v3f = bfhi(vpa[j2]);
        ro[2 * j2] = r0 + (r1 - r0) * mur[2 * j2];
        ro[2 * j2 + 1] = r2 + (r3 - r2) * mur[2 * j2 + 1];
        ko[2 * j2] = k0f + (k1f - k0f) * muk[2 * j2];
        ko[2 * j2 + 1] = k2f + (k3f - k2f) * muk[2 * j2 + 1];
        vo[2 * j2] = v0f + (v1f - v0f) * muv[2 * j2];
        vo[2 * j2 + 1] = v2f2 + (v3f - v2f2) * muv[2 * j2 + 1];
      }
      *(float4*)(rsA + at * 64 + aq * 4) = make_float4(ro[0], ro[1], ro[2], ro[3]);
      *(float4*)(kraw + at * 64 + aq * 4) = make_float4(ko[0], ko[1], ko[2], ko[3]);
      {
        const float4 kc4 = *(const float4*)(kkcs + aq * 4);
        const float k0 = ko[0] * kc4.x, k1 = ko[1] * kc4.y, k2 = ko[2] * kc4.z, k3 = ko[3] * kc4.w;
        const float ssr = red16(k0 * k0 + k1 * k1 + k2 * k2 + k3 * k3);
        if (aq == 0) kss[at] = ssr;
      }
      *(float4*)(vs + at * 64 + aq * 4) = make_float4(vo[0], vo[1], vo[2], vo[3]);
#pragma unroll
      for (int i = 0; i < 5; ++i) {
        const int j = aq * 10 + 2 * i;
        float x0 = bflo(zc[i]) + bflo(zp[i]);
        float x1 = bfhi(zc[i]) + bfhi(zp[i]);
        if (j < 64) { x0 = fast_tanh(x0); x1 = fast_tanh(x1); }
        *(unsigned*)(L1b + at * 168 + j) = pack2(x0, x1);
      }
    }
    __syncthreads();
    {
      int tL = tid; asm volatile("" : "+v"(tL));
      const int fr = tL & 15, fq = (tL & 63) >> 4;
      f32x4 accw = {0.f, 0.f, 0.f, 0.f}, acca = {0.f, 0.f, 0.f, 0.f}, accv = {0.f, 0.f, 0.f, 0.f};
#pragma unroll
      for (int ks = 0; ks < 2; ++ks) {
        bf16x8 af = *(const bf16x8*)(L1b + fr * 168 + ks * 32 + fq * 8);
        accw = __builtin_amdgcn_mfma_f32_16x16x32_bf16(af, w2f[ks], accw, 0, 0, 0);
        bf16x8 ag = *(const bf16x8*)(L1b + fr * 168 + 64 + ks * 32 + fq * 8);
        acca = __builtin_amdgcn_mfma_f32_16x16x32_bf16(ag, a2f[ks], acca, 0, 0, 0);
      }
      if (e >= 1) {
        bf16x8 ah = *(const bf16x8*)(L1b + fr * 168 + 128 + fq * 8);
        accv = __builtin_amdgcn_mfma_f32_16x16x32_bf16(ah, v2f, accv, 0, 0, 0);
      }
#pragma unroll
      for (int i = 0; i < 4; ++i) {
        pre_w[(4 * fq + i) * 64 + wid * 16 + fr] = accw[i];
        pre_a[(4 * fq + i) * 64 + wid * 16 + fr] = acca[i];
        pre_v[(4 * fq + i) * 64 + wid * 16 + fr] = accv[i];
      }
    }
    __syncthreads();
    float qa[4], qb[4], qk[4], qr[4], qv[4], qld[4];
    {
      int tB = tid; asm volatile("" : "+v"(tB));
      const int bch = tB & 63;
      float lsum = 0.f;
#pragma unroll
      for (int i = 0; i < 4; ++i) {
        const int t = btg * 4 + i;
        const size_t tok = tokbase + c0 + t;
        const float wpre = w0 + pre_w[t * 64 + bch];
        const float wlog = -fast_softplus(-wpre) - 0.5f;
        const float ld = -__expf(wlog);
        const float icl = sigm(a0 + pre_a[t * 64 + bch]);
        const float k = kraw[t * 64 + bch];
        const float r = rsA[t * 64 + bch];
        float vv = vs[t * 64 + bch];
        if (e >= 1) {
          const float vg = sigm(v0c + pre_v[t * 64 + bch]);
          const float vf = bf2f(vfc[i]);
          vv = vv + (vf - vv) * vg;
        } else {
          p.vfirst[tok * 512 + bcg] = f2bf(vv);
        }
        const float kkv = k * kkc;
        const float ss = kss[t];
        const float kkn = kkv * rsqrtf(fmaxf(ss, 1e-24f));
        const float kh = k * (1.f + (icl - 1.f) * kac);
        rsA[t * 64 + bch] = r * kh * rkc;
        qa[i] = -kkn;
        qb[i] = kkn * icl;
        qk[i] = kh;
        qr[i] = r;
        qv[i] = vv;
        qld[i] = ld;
        lsum += ld;
        vs[t * 64 + bch] = vv;
      }
      ldsum[btg * 64 + bch] = lsum;
    }
    __syncthreads();
    {
      int tB = tid; asm volatile("" : "+v"(tB));
      const int bch = tB & 63;
      float c = 0.f;
      for (int g = 0; g < btg; ++g) c += ldsum[g * 64 + bch];
      const float cref = ldsum[bch] + ldsum[64 + bch];
#pragma unroll
      for (int i = 0; i < 4; ++i) {
        const int t = btg * 4 + i;
        const float eprev = __expf(c - cref);
        c += qld[i];
        const float ecur = __expf(c - cref), einv = __expf(cref - c);
        At[t * 72 + bch] = f2h(qa[i] * eprev);
        Rt[t * 72 + bch] = f2h(qr[i] * ecur);
        const unsigned short bb = f2h(qb[i] * einv), kb = f2h(qk[i] * einv);
        Bt[t * 72 + bch] = bb;
        Kt[t * 72 + bch] = kb;
        BKT[bch * 40 + t] = bb;
        BKT[bch * 40 + 16 + t] = kb;
        VmT[bch * 24 + t] = f2h(qv[i]);
      }
      if (btg == 3) {
        gL[bch] = __expf(c);
        gLm[bch] = __expf(c - cref);
        gm[bch] = __expf(cref);
      }
    }
    __syncthreads();
    if (c0 + 16 < SEQ) load_chunk(c0 + 16);
    {
      int tC = tid; asm volatile("" : "+v"(tC));
      const int lane = tC & 63, fr = tC & 15, fq = (tC & 63) >> 4;
      *(uint2*)(MakT + (lane >> 2) * 40 + (lane & 3) * 4) = make_uint2(0u, 0u);
#pragma unroll
      for (int nt = 0; nt < 4; ++nt) {
        const float gmk = gm[nt * 16 + fr];
#pragma unroll
        for (int i = 0; i < 4; ++i) S0b[(wid * 16 + 4 * fq + i) * 72 + nt * 16 + fr] = f2h(Sacc[nt][i] * gmk);
      }
      f16x8 aF[2], rF[2], bF[2], kF[2], sF[2];
#pragma unroll
      for (int ks = 0; ks < 2; ++ks) {
        aF[ks] = *(const f16x8*)(At + fr * 72 + ks * 32 + fq * 8);
        rF[ks] = *(const f16x8*)(Rt + fr * 72 + ks * 32 + fq * 8);
        bF[ks] = *(const f16x8*)(Bt + fr * 72 + ks * 32 + fq * 8);
        kF[ks] = *(const f16x8*)(Kt + fr * 72 + ks * 32 + fq * 8);
        sF[ks] = *(const f16x8*)(S0b + (wid * 16 + fr) * 72 + ks * 32 + fq * 8);
      }
      const f32x4 zz = {0.f, 0.f, 0.f, 0.f};
      f32x4 qab = __builtin_amdgcn_mfma_f32_16x16x32_f16(aF[0], bF[0], zz, 0, 0, 0);
      qab = __builtin_amdgcn_mfma_f32_16x16x32_f16(aF[1], bF[1], qab, 0, 0, 0);
      f32x4 qak = __builtin_amdgcn_mfma_f32_16x16x32_f16(aF[0], kF[0], zz, 0, 0, 0);
      qak = __builtin_amdgcn_mfma_f32_16x16x32_f16(aF[1], kF[1], qak, 0, 0, 0);
      f32x4 qrb = __builtin_amdgcn_mfma_f32_16x16x32_f16(rF[0], bF[0], zz, 0, 0, 0);
      qrb = __builtin_amdgcn_mfma_f32_16x16x32_f16(rF[1], bF[1], qrb, 0, 0, 0);
      f32x4 qrk = __builtin_amdgcn_mfma_f32_16x16x32_f16(rF[0], kF[0], zz, 0, 0, 0);
      qrk = __builtin_amdgcn_mfma_f32_16x16x32_f16(rF[1], kF[1], qrk, 0, 0, 0);
      f32x4 x1 = __builtin_amdgcn_mfma_f32_16x16x32_f16(aF[0], sF[0], zz, 0, 0, 0);
      x1 = __builtin_amdgcn_mfma_f32_16x16x32_f16(aF[1], sF[1], x1, 0, 0, 0);
      f32x4 x2 = __builtin_amdgcn_mfma_f32_16x16x32_f16(rF[0], sF[0], zz, 0, 0, 0);
      x2 = __builtin_amdgcn_mfma_f32_16x16x32_f16(rF[1], sF[1], x2, 0, 0, 0);
      *(float4*)(Nt + fr * 16 + 4 * fq) = make_float4((fr < 4 * fq + 0) ? qab[0] : 0.f, (fr < 4 * fq + 1) ? qab[1] : 0.f,
                                                       (fr < 4 * fq + 2) ? qab[2] : 0.f, (fr < 4 * fq + 3) ? qab[3] : 0.f);
#pragma unroll
      for (int i = 0; i < 4; ++i) {
        const int t = 4 * fq + i, j = fr;
        MakT[t * 40 + 16 + j] = f2h((j < t) ? qak[i] : 0.f);
        MT2[t * 40 + j] = f2h((j <= t) ? qrb[i] : 0.f);
        MT2[t * 40 + 16 + j] = f2h((j <= t) ? qrk[i] : 0.f);
      }
      __builtin_amdgcn_sched_barrier(0);
      f16x8 vmF = (f16x8){0, 0, 0, 0, 0, 0, 0, 0};
      if (fq >= 2) vmF = *(const f16x8*)(VmT + (wid * 16 + fr) * 24 + (fq - 2) * 8);
      const f16x8 makF = *(const f16x8*)(MakT + fr * 40 + fq * 8);
      x1 = __builtin_amdgcn_mfma_f32_16x16x32_f16(makF, vmF, x1, 0, 0, 0);
      *(float4*)(Pbuf + fr * 20 + 4 * fq) = make_float4(x1[0], x1[1], x1[2], x1[3]);
      __builtin_amdgcn_sched_barrier(0);
      float P[16];
#pragma unroll
      for (int q4 = 0; q4 < 4; ++q4) {
        const float4 pv4 = *(const float4*)(Pbuf + fr * 20 + 4 * q4);
        P[4 * q4 + 0] = pv4.x; P[4 * q4 + 1] = pv4.y; P[4 * q4 + 2] = pv4.z; P[4 * q4 + 3] = pv4.w;
      }
#pragma unroll
      for (int j = 0; j < 15; ++j) {
        float ncol[16];
#pragma unroll
        for (int q4 = (j + 1) / 4; q4 < 4; ++q4) {
          const float4 n4 = *(const float4*)(Nt + j * 16 + 4 * q4);
          ncol[4 * q4 + 0] = n4.x; ncol[4 * q4 + 1] = n4.y; ncol[4 * q4 + 2] = n4.z; ncol[4 * q4 + 3] = n4.w;
        }
        const float pj = P[j];
#pragma unroll
        for (int t = j + 1; t < 16; ++t) P[t] = fmaf(pj, ncol[t], P[t]);
      }
      __builtin_amdgcn_sched_barrier(0);
      f16x8 pvF = vmF;
      if (fq == 0) {
#pragma unroll
        for (int i = 0; i < 8; ++i) pvF[i] = (_Float16)P[i];
      } else if (fq == 1) {
#pragma unroll
        for (int i = 0; i < 8; ++i) pvF[i] = (_Float16)P[8 + i];
      }
      const f16x8 mt2F = *(const f16x8*)(MT2 + fr * 40 + fq * 8);
      x2 = __builtin_amdgcn_mfma_f32_16x16x32_f16(mt2F, pvF, x2, 0, 0, 0);
#pragma unroll
      for (int i = 0; i < 4; ++i) yb[(4 * fq + i) * 64 + wid * 16 + fr] = x2[i];
      __builtin_amdgcn_sched_barrier(0);
#pragma unroll
      for (int nt = 0; nt < 4; ++nt) {
        const f16x8 bkF = *(const f16x8*)(BKT + (nt * 16 + fr) * 40 + fq * 8);
        const f32x4 dS = __builtin_amdgcn_mfma_f32_16x16x32_f16(pvF, bkF, zz, 0, 0, 0);
        const float g = gL[nt * 16 + fr], g2 = gLm[nt * 16 + fr];
#pragma unroll
        for (int i = 0; i < 4; ++i) Sacc[nt][i] = Sacc[nt][i] * g + dS[i] * g2;
      }
    }
    __syncthreads();
    {
      int tD = tid; asm volatile("" : "+v"(tD));
      const int at = tD >> 4, aq = tD & 15;
      const size_t tok = tokbase + c0 + at;
      const float4 y4 = *(const float4*)(yb + at * 64 + aq * 4);
      const float4 v4 = *(const float4*)(vs + at * 64 + aq * 4);
      const float yv[4] = {y4.x, y4.y, y4.z, y4.w};
      const float vv4[4] = {v4.x, v4.y, v4.z, v4.w};
      const float mean = red16(yv[0] + yv[1] + yv[2] + yv[3]) * (1.f / 64.f);
      float q = 0.f;
#pragma unroll
      for (int j = 0; j < 4; ++j) { float d = yv[j] - mean; q += d * d; }
      q = red16(q);
      const float rstd = rsqrtf(q * (1.f / 64.f) + 64e-5f);
      const float4 pc4 = *(const float4*)(rsA + at * 64 + aq * 4);
      const float cb = red16(pc4.x + pc4.y + pc4.z + pc4.w);
      const float4 gg4 = *(const float4*)(cst + 192 + aq * 4), gb4 = *(const float4*)(cst + 256 + aq * 4);
      const float gng[4] = {gg4.x, gg4.y, gg4.z, gg4.w}, gnb[4] = {gb4.x, gb4.y, gb4.z, gb4.w};
      const float g[4] = {bflo(gcur.x), bfhi(gcur.x), bflo(gcur.y), bfhi(gcur.y)};
      float o[4];
#pragma unroll
      for (int j = 0; j < 4; ++j) {
        float yn = (yv[j] - mean) * rstd * gng[j] + gnb[j] + cb * vv4[j];
        o[j] = yn * silu(g[j]);
      }
      uint2 ov;
      ov.x = pack2(o[0], o[1]);
      ov.y = pack2(o[2], o[3]);
      *(uint2*)(p.mixb + tok * 512 + h * 64 + aq * 4) = ov;
    }
    __syncthreads();
  }
}


__device__ void phase_mixers(const Params& p, int e, char* smem) {
  const int b = blockIdx.x;
  if (gridDim.x == 512) {
    if (b < 128) { for (int rr = 0; rr < REP_R; ++rr) rwkv_item(p, e, b, smem); }
    else if (b < 256) { for (int rr = 0; rr < REP_H; ++rr) hgrn2_item(p, e, b - 128, smem); }
    else if (b >= 384) { for (int rr = 0; rr < REP_H; ++rr) hgrn2_item(p, e, b - 256, smem); }
  } else {
    for (int item = blockIdx.x; item < 384; item += gridDim.x) {
      if (item < 256) { for (int rr = 0; rr < REP_H; ++rr) hgrn2_item(p, e, item, smem); }
      else { for (int rr = 0; rr < REP_R; ++rr) rwkv_item(p, e, item - 256, smem); }
    }
  }
}

__device__ void phase_hpost(const Params& p, int e) {
  const int lane = otid() & 63, wid = otid() >> 6;
  const int nw = gridDim.x * 4;
  const int c = lane * 8;
  float ng[8];
#pragma unroll
  for (int j = 0; j < 8; ++j) ng[j] = p.a_ng[e * 512 + c + j];
  for (int tok0 = (blockIdx.x * 4 + wid) * 4; tok0 < NTOK; tok0 += nw * 4) {
    float4 o0[4], o1[4];
    uint4 gv[4];
#pragma unroll
    for (int rr = 0; rr < 4; ++rr) {
      const float* o = p.oraw + (size_t)(tok0 + rr) * 512 + c;
      o0[rr] = *(const float4*)o;
      o1[rr] = *(const float4*)(o + 4);
      gv[rr] = *(const uint4*)(p.u + (size_t)(tok0 + rr) * UE + C_GA + c);
    }
#pragma unroll
    for (int rr = 0; rr < 4; ++rr) {
      float ov[8] = {o0[rr].x, o0[rr].y, o0[rr].z, o0[rr].w, o1[rr].x, o1[rr].y, o1[rr].z, o1[rr].w};
      float ss = 0.f;
#pragma unroll
      for (int j = 0; j < 8; ++j) ss += ov[j] * ov[j];
#pragma unroll
      for (int m = 8; m >= 1; m >>= 1) ss += __shfl_xor(ss, m);
      const float rs = rsqrtf(ss * (1.f / 128.f) + 1e-6f);
      unsigned ga[4] = {gv[rr].x, gv[rr].y, gv[rr].z, gv[rr].w};
      float r[8];
#pragma unroll
      for (int j = 0; j < 8; ++j) {
        float g = bf2f((unsigned short)((ga[j >> 1] >> ((j & 1) * 16)) & 0xffff));
        r[j] = ov[j] * rs * ng[j] * silu(g);
      }
      uint4 w;
      w.x = pack2(r[0], r[1]); w.y = pack2(r[2], r[3]); w.z = pack2(r[4], r[5]); w.w = pack2(r[6], r[7]);
      *(uint4*)(p.act + (size_t)(tok0 + rr) * DM + c) = w;
    }
  }
}

__device__ void phase_conv(const Params& p, int o) {
  const float* cw = p.od_cw + (size_t)o * 4 * 1024;
  const float* cbp = p.od_cb + (size_t)o * 1024;
  const int tid = otid();
  const int c = (tid & 127) * 8;
  float wt[4][8], bias[8];
#pragma unroll
  for (int j = 0; j < 8; ++j) {
    bias[j] = cbp[c + j];
#pragma unroll
    for (int w = 0; w < 4; ++w) wt[w][j] = cw[w * 1024 + c + j];
  }
  for (int tok = (int)blockIdx.x * 2 + (tid >> 7); tok < NTOK; tok += (int)gridDim.x * 2) {
    const int t = tok & (SEQ - 1);
    uint4 xv[4];
#pragma unroll
    for (int w = 0; w < 4; ++w) {
      xv[w] = make_uint4(0u, 0u, 0u, 0u);
      if (t + w - 3 >= 0) xv[w] = *(const uint4*)(p.u + (size_t)(tok + w - 3) * UO + c);
    }
    float acc[8];
#pragma unroll
    for (int j = 0; j < 8; ++j) acc[j] = bias[j];
#pragma unroll
    for (int w = 0; w < 4; ++w) {
      const unsigned xa[4] = {xv[w].x, xv[w].y, xv[w].z, xv[w].w};
#pragma unroll
      for (int j2 = 0; j2 < 4; ++j2) {
        acc[2 * j2] += wt[w][2 * j2] * bflo(xa[j2]);
        acc[2 * j2 + 1] += wt[w][2 * j2 + 1] * bfhi(xa[j2]);
      }
    }
    uint4 ov;
    ov.x = pack2(acc[0], acc[1]); ov.y = pack2(acc[2], acc[3]); ov.z = pack2(acc[4], acc[5]); ov.w = pack2(acc[6], acc[7]);
    *(uint4*)(p.act + (size_t)tok * DM + c) = ov;
  }
}

__device__ __forceinline__ float neg_expm1_fast(float x) {
  const float ser = -x * (1.f + x * (0.5f + x * (0.16666667f + x * 0.041666668f)));
  const float big = 1.f - __expf(x);
  return (x > -0.125f) ? ser : big;
}

__device__ void phase_gates(const Params& p, int o, char* smem) {
  const int ntiles = 4 * 256 * 4;
  const int lane = otid() & 63, wid = otid() >> 6, wr = wid >> 1, wc = wid & 1, fr = lane & 15, fq = lane >> 4;
  const int tpx = ntiles >> 3, nbx = gridDim.x >> 3, xcd = blockIdx.x & 7;
  GEMM_SLOTS_DECL
  bool preloaded = false;
  for (int lt = (gridDim.x == 512) ? ((((blockIdx.x >> 3) & 31) << 1) + (blockIdx.x >> 8)) : (blockIdx.x >> 3); lt < tpx; lt += nbx) {
    const int t = xcd * tpx + lt;
    const int g = t >> 10, r = t & 1023, m0 = (r >> 2) * 128, ntile = r & 3;
    const bool more = (lt + nbx < tpx);
    const int t2 = t + nbx, g2 = t2 >> 10, r2 = t2 & 1023;
    const bf16_t* nA = more ? (p.act + (size_t)((r2 >> 2) * 128) * DM + g2 * 256) : nullptr;
    const bf16_t* nB = more ? (p.wg + (size_t)(o * 4 + g2) * 512 * 256 + (size_t)(r2 & 3) * 128 * 256) : nullptr;
    f32x4 acc[4][4];
    gemm_mainloop(p.act + (size_t)m0 * DM + g * 256, DM, p.wg + (size_t)(o * 4 + g) * 512 * 256 + (size_t)ntile * 128 * 256,
                  256, 256, acc, smem, p.act, DM, 1 << 20, GEMM_SLOTS_ARGS, preloaded, nA, nB);
    preloaded = more;
#pragma unroll
    for (int hf = 0; hf < 2; ++hf) {
      const int col = g * 256 + ntile * 64 + wc * 32 + hf * 16 + fq * 4;
      float4 ba = *(const float4*)(p.od_ba + o * 1024 + col);
      float4 bx = *(const float4*)(p.od_bx + o * 1024 + col);
      float4 lm = *(const float4*)(p.od_lam + o * 1024 + col);
      float bav[4] = {ba.x, ba.y, ba.z, ba.w}, bxv[4] = {bx.x, bx.y, bx.z, bx.w}, lmv[4] = {lm.x, lm.y, lm.z, lm.w};
      float spl[4];
#pragma unroll
      for (int j = 0; j < 4; ++j) spl[j] = fast_softplus(-lmv[j]);
#pragma unroll
      for (int mt = 0; mt < 4; ++mt) {
        const int m = m0 + wr * 64 + mt * 16 + fr;
        uint2 xv = *(const uint2*)(p.act + (size_t)m * DM + col);
        unsigned xa[2] = {xv.x, xv.y};
        float lav[4], uv[4];
#pragma unroll
        for (int j = 0; j < 4; ++j) {
          const float gr = sigm(acc[mt][hf * 2][j] + bav[j]);
          const float gi = sigm(acc[mt][hf * 2 + 1][j] + bxv[j]);
          const float la = bf2f(f2bf(-8.f * gr * spl[j]));
          const float xc = bf2f((unsigned short)((xa[j >> 1] >> ((j & 1) * 16)) & 0xffff));
          lav[j] = la;
          uv[j] = __builtin_amdgcn_sqrtf(neg_expm1_fast(2.f * la)) * gi * xc;
        }
        { uint2 lo; lo.x = pack2(lav[0], lav[1]); lo.y = pack2(lav[2], lav[3]); *(uint2*)(p.la + (size_t)m * DM + col) = lo; }
        uint2 uo;
        uo.x = pack2(uv[0], uv[1]);
        uo.y = pack2(uv[2], uv[3]);
        *(uint2*)(p.uin + (size_t)m * DM + col) = uo;
      }
    }
  }
}

__device__ void phase_scan(const Params& p, char* smem) {
  float* sL = (float*)smem;
  float* sH = sL + 1024;
  const int tid = otid(), cq = tid & 7, seg = tid >> 3;
  for (int item = blockIdx.x; item < 512; item += gridDim.x) {
    const int b = item >> 5, c = (item & 31) * 32 + cq * 4;
    const size_t base = ((size_t)b * SEQ + seg * 64) * DM + c;
    float L[4] = {0.f, 0.f, 0.f, 0.f}, h[4] = {0.f, 0.f, 0.f, 0.f};
#pragma unroll 8
    for (int t = 0; t < 64; ++t) {
      const uint2 lab = *(const uint2*)(p.la + base + (size_t)t * DM);
      const float4 la = make_float4(bflo(lab.x), bfhi(lab.x), bflo(lab.y), bfhi(lab.y));
      const uint2 uu = *(const uint2*)(p.uin + base + (size_t)t * DM);
      h[0] = __expf(la.x) * h[0] + bflo(uu.x);
      h[1] = __expf(la.y) * h[1] + bfhi(uu.x);
      h[2] = __expf(la.z) * h[2] + bflo(uu.y);
      h[3] = __expf(la.w) * h[3] + bfhi(uu.y);
      L[0] += la.x; L[1] += la.y; L[2] += la.z; L[3] += la.w;
    }
    *(float4*)(sL + seg * 32 + cq * 4) = make_float4(L[0], L[1], L[2], L[3]);
    *(float4*)(sH + seg * 32 + cq * 4) = make_float4(h[0], h[1], h[2], h[3]);
    __syncthreads();
    float hc[4] = {0.f, 0.f, 0.f, 0.f};
    for (int s2 = 0; s2 < seg; ++s2) {
      const float4 l4 = *(const float4*)(sL + s2 * 32 + cq * 4);
      const float4 h4 = *(const float4*)(sH + s2 * 32 + cq * 4);
      hc[0] = __expf(l4.x) * hc[0] + h4.x;
      hc[1] = __expf(l4.y) * hc[1] + h4.y;
      hc[2] = __expf(l4.z) * hc[2] + h4.z;
      hc[3] = __expf(l4.w) * hc[3] + h4.w;
    }
    h[0] = hc[0]; h[1] = hc[1]; h[2] = hc[2]; h[3] = hc[3];
    const size_t gbase = ((size_t)b * SEQ + seg * 64) * UO + 1024 + c;
#pragma unroll 8
    for (int t = 0; t < 64; ++t) {
      const uint2 lab = *(const uint2*)(p.la + base + (size_t)t * DM);
      const float4 la = make_float4(bflo(lab.x), bfhi(lab.x), bflo(lab.y), bfhi(lab.y));
      const uint2 uu = *(const uint2*)(p.uin + base + (size_t)t * DM);
      const uint2 gg = *(const uint2*)(p.u + gbase + (size_t)t * UO);
      h[0] = __expf(la.x) * h[0] + bflo(uu.x);
      h[1] = __expf(la.y) * h[1] + bfhi(uu.x);
      h[2] = __expf(la.z) * h[2] + bflo(uu.y);
      h[3] = __expf(la.w) * h[3] + bfhi(uu.y);
      uint2 o;
      o.x = pack2(h[0] * silu(bflo(gg.x)), h[1] * silu(bfhi(gg.x)));
      o.y = pack2(h[2] * silu(bflo(gg.y)), h[3] * silu(bfhi(gg.y)));
      *(uint2*)(p.act + base + (size_t)t * DM) = o;
    }
    __syncthreads();
  }
}


#define XB_TMO      128
#define XB_XCNT(j)  (256  + 64 * (j))
#define XB_XSUB(j)  (1280 + 64 * (j))
#define XB_XGEN(j)  (2304 + 64 * (j))
#define XB_TOP      3328
#define XB_TOPGEN   3392
#define XCD_BAR_WORDS 3456
#define XB_SPIN_CAP (1u << 22)
#define LAS __attribute__((address_space(3)))
__device__ __forceinline__ unsigned xb_ld(unsigned* p) { return __hip_atomic_load(p, __ATOMIC_RELAXED, __HIP_MEMORY_SCOPE_AGENT); }
__device__ __forceinline__ unsigned xb_add(unsigned* p, unsigned v) { return __hip_atomic_fetch_add(p, v, __ATOMIC_RELAXED, __HIP_MEMORY_SCOPE_AGENT); }
__device__ __forceinline__ unsigned xb_xcc_id() { return (unsigned)__builtin_amdgcn_s_getreg((3 << 11) | 20) & 0xFu; }
#define XB_SPIN(cond, bar) do { unsigned _sp = 0; while (cond) { __builtin_amdgcn_s_sleep(1); \
    if ((++_sp & 255u) == 0u) { if (xb_ld(&(bar)[XB_TMO])) break; if (_sp > XB_SPIN_CAP) { atomicAdd(&(bar)[XB_TMO], 1u); break; } } } } while (0)
struct XcdBarrier { unsigned* bar; unsigned x; volatile LAS unsigned* st; unsigned total; };
__device__ __forceinline__ XcdBarrier xcd_barrier_post(unsigned* bar, volatile LAS unsigned* st, unsigned total) {
  XcdBarrier b; b.bar = bar; b.x = xb_xcc_id(); b.st = st; b.total = total;
  if (threadIdx.x == 0) (void)xb_add(&bar[XB_XCNT(b.x)], 1u);
  return b;
}
__device__ __forceinline__ void xcd_barrier_complete(unsigned* bar, unsigned x, unsigned& nloc, unsigned& nx, unsigned G) {
  unsigned sum, cnt, mine, sp = 0u;
  for (;;) {
    sum = 0u; cnt = 0u; mine = 0u;
#pragma unroll
    for (unsigned j = 0; j < 16; ++j) { const unsigned c = xb_ld(&bar[XB_XCNT(j)]); sum += c; cnt += (c > 0u) ? 1u : 0u; mine = (j == x) ? c : mine; }
    if (sum == G) break;
    __builtin_amdgcn_s_sleep(1);
    if ((++sp & 255u) == 0u) { if (xb_ld(&bar[XB_TMO])) break; if (sp > XB_SPIN_CAP) { atomicAdd(&bar[XB_TMO], 1u); break; } }
  }
  nloc = mine > 0u ? mine : 1u; nx = cnt > 0u ? cnt : 1u;
}
__device__ __forceinline__ void xcd_barrier(const XcdBarrier& b) {
  asm volatile("s_waitcnt vmcnt(0)" ::: "memory");
  __syncthreads();
  if (threadIdx.x == 0) {
    unsigned* bar = b.bar;
    asm volatile("" : "+v"(bar));
    __builtin_amdgcn_s_waitcnt(0);
    unsigned nloc = b.st[0], nx = b.st[1];
    if (nloc == 0u) { xcd_barrier_complete(bar, b.x, nloc, nx, b.total); b.st[0] = nloc; b.st[1] = nx; }
    const unsigned old = xb_add(&bar[XB_XSUB(b.x)], 1u);
    const unsigned gen = old / nloc;
    if (old + 1u == (gen + 1u) * nloc) {
      __builtin_amdgcn_fence(__ATOMIC_RELEASE, "agent");
      asm volatile("s_waitcnt vmcnt(0)" ::: "memory");
      const unsigned og = xb_add(&bar[XB_TOP], 1u);
      const unsigned tg = og / nx;
      if (og + 1u == (tg + 1u) * nx) xb_add(&bar[XB_TOPGEN], 1u);
      else XB_SPIN(xb_ld(&bar[XB_TOPGEN]) == tg, bar);
      __builtin_amdgcn_fence(__ATOMIC_ACQUIRE, "agent");
      xb_add(&bar[XB_XGEN(b.x)], 1u);
      asm volatile("s_waitcnt vmcnt(0)" ::: "memory");
    } else {
      XB_SPIN(xb_ld(&bar[XB_XGEN(b.x)]) == gen, bar);
      __builtin_amdgcn_fence(__ATOMIC_ACQUIRE, "agent");
      asm volatile("s_waitcnt vmcnt(0)" ::: "memory");
    }
  }
  __syncthreads();
}

__device__ __forceinline__ void sub_barrier(unsigned* cnt, unsigned target) {
  asm volatile("s_waitcnt vmcnt(0)" ::: "memory");
  __syncthreads();
  if (threadIdx.x == 0) {
    __builtin_amdgcn_fence(__ATOMIC_RELEASE, "agent");
    asm volatile("s_waitcnt vmcnt(0)" ::: "memory");
    (void)xb_add(cnt, 1u);
    unsigned sp = 0;
    while (xb_ld(cnt) < target) { __builtin_amdgcn_s_sleep(2); if (++sp > (1u << 26)) break; }
    __builtin_amdgcn_fence(__ATOMIC_ACQUIRE, "agent");
    asm volatile("s_waitcnt vmcnt(0)" ::: "memory");
  }
  __syncthreads();
}

__device__ void phase_mixers_overlap(const Params& p, int e, char* smem, const XcdBarrier& xb2) {
  const int b = blockIdx.x;
  if (b < 128) {
    rwkv_item(p, e, b, smem);
  } else {
    phase_gemm_in_range(p, p.wev_in + (size_t)e * UE * 1024, UE, 0, 12, 128, 384, smem);
    xcd_barrier(xb2);
    if (b < 256) hgrn2_item(p, e, b - 128, smem);
    else if (b >= 384) hgrn2_item(p, e, b - 256, smem);
    else phase_gemm_in_range(p, p.wev_in + (size_t)e * UE * 1024, UE, 12, 4, 256, 128, smem);
  }
}

__global__ void __launch_bounds__(NTHR, 2) __attribute__((amdgpu_num_vgpr(NVGPR_CAP))) mega_kernel(Params p) {
  __shared__ __attribute__((aligned(16))) char smem[SMEM_BYTES];
  cg::grid_group grid = cg::this_grid();
  __shared__ uint4 xb_words;
  if (threadIdx.x == 0) xb_words = make_uint4(0u, 0u, 0u, 0u);
  __syncthreads();
  XcdBarrier xb = xcd_barrier_post(p.bar, (volatile LAS unsigned*)&xb_words, gridDim.x);
  XcdBarrier xb2 = xb;
  xb2.bar = p.bar + XCD_BAR_WORDS; xb2.st = (volatile LAS unsigned*)&xb_words.z; xb2.total = 384u;
  if (gridDim.x == 512 && blockIdx.x >= 128 && threadIdx.x == 0) (void)xb_add(&xb2.bar[XB_XCNT(xb2.x)], 1u);
  for (int rep = 0; rep < REP_PRE; ++rep) {
  PH_PREP(phase_prep(p, smem);)
  if (p.never) grid.sync();
  xcd_barrier(xb);
  PH_H0(phase_h0(p);)
  xcd_barrier(xb);
  }
#pragma unroll 1
  for (int l = 0; l < 4; ++l) {
    const int idx = l >> 1;
    const bf16_t* wout;
    if ((l & 1) == 0) {
      if (gridDim.x == 512) {
        phase_gemm_in_range(p, p.wev_in + (size_t)idx * UE * 1024, UE, 16, 19, 0, 512, smem);
        xcd_barrier(xb);
        phase_mixers_overlap(p, idx, smem, xb2);
        xcd_barrier(xb);
      } else {
        phase_gemm_in(p, p.wev_in + (size_t)idx * UE * 1024, UE, UE, smem);
        xcd_barrier(xb);
        phase_mixers(p, idx, smem);
        xcd_barrier(xb);
      }
      for (int rep = 0; rep < REP_HP; ++rep) { PH_HPOST(phase_hpost(p, idx);)
      xcd_barrier(xb); }
      wout = p.wev_out + (size_t)idx * 1024 * 1024;
    } else {
      PH_GIN(phase_gemm_in(p, p.wod_in + (size_t)idx * 2048 * 1024, UO, UO, smem);)
      xcd_barrier(xb);
      for (int rep = 0; rep < REP_ODD; ++rep) { PH_CONV(phase_conv(p, idx);)
      xcd_barrier(xb);
      PH_GATES(phase_gates(p, idx, smem);)
      xcd_barrier(xb);
      PH_SCAN(phase_scan(p, smem);)
      xcd_barrier(xb); }
      wout = p.wod_out + (size_t)idx * 1024 * 1024;
    }
    PH_GOUT(phase_gemm_out(p, l, wout, smem, (l & 1) == 0);)
    xcd_barrier(xb);
    PH_LN(phase_ln(p, l);)
    if (l < 3) xcd_barrier(xb);
  }
}

extern "C" void kernel_launch(void* const* d_in, const int* in_sizes, int n_in, void* d_out, int out_size, void* d_ws,
                              size_t ws_size, hipStream_t stream) {
  static int grid_blocks = 0;
  if (!grid_blocks) {
    int dev = 0, cus = 0, per_cu = 0;
    hipGetDevice(&dev);
    hipDeviceGetAttribute(&cus, hipDeviceAttributeMultiprocessorCount, dev);
    hipOccupancyMaxActiveBlocksPerMultiprocessor(&per_cu, mega_kernel, NTHR, 0);
    if (per_cu < 1) per_cu = 1;
    if (per_cu > 2) per_cu = 2;
    grid_blocks = cus * per_cu;
  }
  Params p{};
  const float* const* in = (const float* const*)d_in;
  p.x = in[0]; p.c = in[1]; p.ada_w = in[2]; p.ada_b = in[3]; p.ln_g = in[4]; p.ln_b = in[5];
  p.ev_w_in = in[6]; p.ev_w_out = in[7]; p.a_lb = in[8]; p.a_ng = in[9]; p.b_mu = in[10]; p.b_w0 = in[11];
  p.b_w1 = in[12]; p.b_w2 = in[13]; p.b_a0 = in[14]; p.b_a1 = in[15]; p.b_a2 = in[16]; p.b_kk = in[17];
  p.b_ka = in[18]; p.b_rk = in[19]; p.b_gng = in[20]; p.b_gnb = in[21]; p.b_vmu = in[22]; p.b_v0 = in[23];
  p.b_v1 = in[24]; p.b_v2 = in[25]; p.od_w_in = in[26]; p.od_cw = in[27]; p.od_cb = in[28]; p.od_wa = in[29];
  p.od_ba = in[30]; p.od_wx = in[31]; p.od_bx = in[32]; p.od_lam = in[33]; p.od_w_out = in[34];
  p.out = (float*)d_out;
  char* ws = (char*)d_ws;
  const size_t MiB = 1024 * 1024;
  p.mod = (float*)(ws);
  p.wev_in = (bf16_t*)(ws + 1 * MiB);
  p.wev_out = (bf16_t*)(ws + 19 * MiB);
  p.wod_in = (bf16_t*)(ws + 23 * MiB);
  p.wod_out = (bf16_t*)(ws + 31 * MiB);
  p.wg = (bf16_t*)(ws + 35 * MiB);
  p.act = (bf16_t*)(ws + 40 * MiB);
  p.vfirst = (bf16_t*)(ws + 104 * MiB);
  p.u = (bf16_t*)(ws + 136 * MiB);
  p.oraw = (float*)(ws + 416 * MiB);
  p.la = (bf16_t*)(ws + 264 * MiB);
  p.uin = (bf16_t*)(ws + 392 * MiB);
  p.bar = (unsigned*)(ws + 900 * 1024);
  p.mixb = (bf16_t*)(ws + 480 * MiB);
  hipMemsetAsync(p.bar, 0, 2 * XCD_BAR_WORDS * sizeof(unsigned), stream);
  void* args[] = {&p};
  hipError_t e = hipLaunchCooperativeKernel((void*)mega_kernel, dim3(grid_blocks), dim3(NTHR), args, 0, stream);
  if (e != hipSuccess) fprintf(stderr, "cooperative launch failed: %s (grid %d)\n", hipGetErrorString(e), grid_blocks);
}
```
